# Optimizing an MI355X kernel written in HIP

```python
import jax
import jax.numpy as jnp
from jax import lax
import numpy as np

D_MODEL = 1024
BATCH = 2
SEQ = 16384
DEPTH = 2

CTX_LEN = 256
GRID_W = 64
BLOCK = 128
HEAD_DIM = 64
ROPE_THETA = 10000.0
EPS = 1e-6
ML_HEADS = 4
ML_DIM = 128
ML_WIDTH = ML_HEADS * ML_DIM
WIN_Q_HEADS = 8
WIN_KV_HEADS = 2
WINDOW = 128
WIN_WIDTH = WIN_Q_HEADS * HEAD_DIM
WIN_KV_WIDTH = WIN_KV_HEADS * HEAD_DIM
GLB_Q_HEADS = 8
GLB_KV_HEADS = 2
GLB_WIDTH = GLB_Q_HEADS * HEAD_DIM
GLB_KV_WIDTH = GLB_KV_HEADS * HEAD_DIM
N_BRANCH = 3
BRANCH_WIDTH = 512
D_FF = ((8 * D_MODEL + 3 * 256 - 1) // (3 * 256)) * 256
SPLITS = (ML_WIDTH, ML_WIDTH, ML_WIDTH, ML_WIDTH, 2 * ML_HEADS, 2 * ML_HEADS,
          WIN_WIDTH, WIN_KV_WIDTH, WIN_KV_WIDTH,
          GLB_WIDTH, GLB_KV_WIDTH, GLB_KV_WIDTH,
          N_BRANCH * D_MODEL)
D_IN = sum(SPLITS)
ML_F_OFF = 4 * ML_WIDTH + 2 * ML_HEADS

kernel_name = 'hybrid_mlstm_swa_axial_gqa_dit'


def rmsnorm(x, g):
    xf = x.astype(jnp.float32)
    y = xf * lax.rsqrt(jnp.mean(xf * xf, axis=-1, keepdims=True) + EPS)
    return (y * g.astype(jnp.float32)).astype(x.dtype)


def modulate(h, shift, scale):
    return h * (1 + scale) + shift


def split_cols(p):
    idx = np.cumsum(SPLITS)[:-1].tolist()
    return jnp.split(p, idx, axis=-1)


def split_heads(a, n_heads):
    b, t, _ = a.shape
    return a.reshape(b, t, n_heads, -1).transpose(0, 2, 1, 3)


def merge_heads(a):
    b, h, t, d = a.shape
    return a.transpose(0, 2, 1, 3).reshape(b, t, h * d)


def axial_angles(n_tok):
    rows = n_tok // GRID_W
    row = jnp.broadcast_to(jnp.arange(rows)[:, None], (rows, GRID_W)).reshape(-1)
    col = jnp.broadcast_to(jnp.arange(GRID_W)[None, :], (rows, GRID_W)).reshape(-1)
    half = HEAD_DIM // 2
    inv = ROPE_THETA ** (-jnp.arange(0, half, 2, dtype=jnp.float32) / half)
    return row.astype(jnp.float32)[:, None] * inv, col.astype(jnp.float32)[:, None] * inv


def rope_1d(x, ang):
    x1, x2 = jnp.split(x, 2, axis=-1)
    cos = jnp.cos(ang).astype(x.dtype)
    sin = jnp.sin(ang).astype(x.dtype)
    return jnp.concatenate([x1 * cos - x2 * sin, x1 * sin + x2 * cos], axis=-1)


def rope_axial(x, ang_row, ang_col):
    xr, xc = jnp.split(x, 2, axis=-1)
    return jnp.concatenate([rope_1d(xr, ang_row), rope_1d(xc, ang_col)], axis=-1)


def zero_state(b, h, d):
    return (jnp.zeros((b, h, d, d), jnp.float32), jnp.zeros((b, h, d), jnp.float32),
            jnp.zeros((b, h), jnp.float32))


def mlstm_scan(q, k, v, ig, lf, state):
    b, h, t, d = q.shape
    nc = t // BLOCK
    out_dtype = q.dtype

    def to_chunks(a):
        a = a.astype(jnp.float32)
        return jnp.moveaxis(a.reshape(b, h, nc, BLOCK, *a.shape[3:]), 2, 0)

    lower = jnp.tril(jnp.ones((BLOCK, BLOCK), bool))
    scale = d ** -0.5

    def step(carry, xs):
        C, n, m = carry
        qc, kc, vc, ic, fc = xs
        qc = qc * scale
        bcum = jnp.cumsum(fc, axis=-1)
        dlog = jnp.where(lower, bcum[..., :, None] - bcum[..., None, :] + ic[..., None, :], -jnp.inf)
        inter = bcum + m[..., None]
        m_t = jnp.maximum(inter, jnp.max(dlog, axis=-1))
        w = jnp.exp(dlog - m_t[..., None])
        a = jnp.exp(inter - m_t)
        s = jnp.einsum('bhtd,bhsd->bhts', qc, kc) * w
        num = a[..., None] * jnp.einsum('bhtd,bhde->bhte', qc, C) + jnp.einsum('bhts,bhse->bhte', s, vc)
        den = a * jnp.einsum('bhtd,bhd->bht', qc, n) + jnp.sum(s, axis=-1)
        hc = num / jnp.maximum(jnp.abs(den), jnp.exp(-m_t))[..., None]
        b_end = bcum[..., -1]
        wlog = b_end[..., None] - bcum + ic
        m_new = jnp.maximum(b_end + m, jnp.max(wlog, axis=-1))
        a_c = jnp.exp(b_end + m - m_new)
        wk = jnp.exp(wlog - m_new[..., None])
        C_new = a_c[..., None, None] * C + jnp.einsum('bhs,bhsd,bhse->bhde', wk, kc, vc)
        n_new = a_c[..., None] * n + jnp.einsum('bhs,bhsd->bhd', wk, kc)
        return (C_new, n_new, m_new), hc

    xs = (to_chunks(q), to_chunks(k), to_chunks(v), to_chunks(ig), to_chunks(lf))
    state, hs = lax.scan(step, state, xs)
    return jnp.moveaxis(hs, 0, 2).reshape(b, h, t, d).astype(out_dtype), state


def flip_if(a, rev):
    return jnp.flip(a, axis=2) if rev else a


def gate_dirs(a):
    b, t, _ = a.shape
    return a.reshape(b, t, 2, ML_HEADS).transpose(2, 0, 3, 1)


def mlstm_branch(lat, ctx, norm_g, ctx_out):
    def prep(parts):
        q, k, v, _, ig, fg = parts
        return (split_heads(q, ML_HEADS), split_heads(k, ML_HEADS), split_heads(v, ML_HEADS),
                gate_dirs(ig), jax.nn.log_sigmoid(gate_dirs(fg).astype(jnp.float32)))

    lq, lk, lv, lig, llf = prep(lat)
    cq, ck, cv, cig, clf = prep(ctx)
    b = lq.shape[0]
    h_lat, h_ctx = [], []
    for dr, rev in enumerate((False, True)):
        hc, st = mlstm_scan(flip_if(cq, rev), flip_if(ck, rev), flip_if(cv, rev),
                            flip_if(cig[dr], rev), flip_if(clf[dr], rev), zero_state(b, ML_HEADS, ML_DIM))
        hl, _ = mlstm_scan(flip_if(lq, rev), flip_if(lk, rev), flip_if(lv, rev),
                           flip_if(lig[dr], rev), flip_if(llf[dr], rev), st)
        h_ctx.append(flip_if(hc, rev))
        h_lat.append(flip_if(hl, rev))

    def finish(hs, o):
        return merge_heads(rmsnorm(hs[0] + hs[1], norm_g[:, None, :])) * jax.nn.sigmoid(o)

    y_lat = finish(h_lat, lat[3])
    y_ctx = finish(h_ctx, ctx[3]) if ctx_out else None
    return y_lat, y_ctx


def window_attention(q, k, v, k_ctx, v_ctx, sink):
    b, hq, n_tok, d = q.shape
    g = k.shape[1]
    r = hq // g
    nb = n_tok // BLOCK
    n_ctx = k_ctx.shape[2]
    scale = d ** -0.5
    qb = jnp.moveaxis(q.reshape(b, g, r, nb, BLOCK, d), 3, 0)

    def band(a):
        ap = jnp.pad(a, ((0, 0), (0, 0), (BLOCK, BLOCK), (0, 0))).reshape(b, g, nb + 2, BLOCK, d)
        a3 = jnp.concatenate([ap[:, :, :-2], ap[:, :, 1:-1], ap[:, :, 2:]], axis=3)
        return jnp.moveaxis(a3, 2, 0)

    kb, vb = band(k), band(v)
    qpos = jnp.arange(n_tok).reshape(nb, BLOCK)
    kpos = jnp.arange(nb)[:, None] * BLOCK - BLOCK + jnp.arange(3 * BLOCK)[None, :]
    valid = ((jnp.abs(qpos[:, :, None] - kpos[:, None, :]) <= WINDOW)
             & (kpos[:, None, :] >= 0) & (kpos[:, None, :] < n_tok))
    sink_g = sink.astype(jnp.float32).reshape(1, g, r, 1, 1)

    def one_block(args):
        qblk, kblk, vblk, ok = args
        s_loc = jnp.where(ok, jnp.einsum('bgrqd,bgkd->bgrqk', qblk, kblk).astype(jnp.float32) * scale, -jnp.inf)
        s_ctx = jnp.einsum('bgrqd,bgkd->bgrqk', qblk, k_ctx).astype(jnp.float32) * scale
        s_snk = jnp.broadcast_to(sink_g, s_ctx.shape[:-1] + (1,))
        p = jax.nn.softmax(jnp.concatenate([s_loc, s_ctx, s_snk], axis=-1), axis=-1).astype(v.dtype)
        return (jnp.einsum('bgrqk,bgkd->bgrqd', p[..., :3 * BLOCK], vblk)
                + jnp.einsum('bgrqk,bgkd->bgrqd', p[..., 3 * BLOCK:3 * BLOCK + n_ctx], v_ctx))

    o = lax.map(one_block, (qb, kb, vb, valid))
    return jnp.moveaxis(o, 0, 3).reshape(b, hq, n_tok, d)


def global_attention(q, k_all, v_all):
    b, hq, n_tok, d = q.shape
    g = k_all.shape[1]
    r = hq // g
    nb = n_tok // BLOCK
    scale = d ** -0.5
    qb = jnp.moveaxis(q.reshape(b, g, r, nb, BLOCK, d), 3, 0)

    def one_block(qblk):
        s = jnp.einsum('bgrqd,bgkd->bgrqk', qblk, k_all).astype(jnp.float32) * scale
        p = jax.nn.softmax(s, axis=-1).astype(v_all.dtype)
        return jnp.einsum('bgrqk,bgkd->bgrqd', p, v_all)

    o = lax.map(one_block, qb)
    return jnp.moveaxis(o, 0, 3).reshape(b, hq, n_tok, d)


def ctx_attention(q, k, v, sink):
    b, hq, n_ctx, d = q.shape
    g = k.shape[1]
    r = hq // g
    s = jnp.einsum('bgrqd,bgkd->bgrqk', q.reshape(b, g, r, n_ctx, d), k).astype(jnp.float32) * d ** -0.5
    if sink is not None:
        s_snk = jnp.broadcast_to(sink.astype(jnp.float32).reshape(1, g, r, 1, 1), s.shape[:-1] + (1,))
        s = jnp.concatenate([s, s_snk], axis=-1)
    p = jax.nn.softmax(s, axis=-1)[..., :n_ctx].astype(v.dtype)
    return jnp.einsum('bgrqk,bgkd->bgrqd', p, v).reshape(b, hq, n_ctx, d)


def merge_branches(ys, gate_logits, w_br, w_o):
    gates = jnp.split(gate_logits, N_BRANCH, axis=-1)
    merged = jax.nn.sigmoid(gates[0]) * (ys[0] @ w_br[0])
    for i in range(1, N_BRANCH):
        merged = merged + jax.nn.sigmoid(gates[i]) * (ys[i] @ w_br[i])
    return merged @ w_o


def token_mixers(hx, hc, w_in, b_in, ml_norm_g, win_sink, qn_g, kn_g, w_br, w_o, ang_row, ang_col, ctx_out):
    px = split_cols(hx @ w_in + b_in)
    pc = split_cols(hc @ w_in + b_in)
    ya_x, ya_c = mlstm_branch(px[0:6], pc[0:6], ml_norm_g, ctx_out)
    wq_x = rope_axial(split_heads(px[6], WIN_Q_HEADS), ang_row, ang_col)
    wk_x = rope_axial(split_heads(px[7], WIN_KV_HEADS), ang_row, ang_col)
    wv_x = split_heads(px[8], WIN_KV_HEADS)
    wk_c = split_heads(pc[7], WIN_KV_HEADS)
    wv_c = split_heads(pc[8], WIN_KV_HEADS)
    yb_x = merge_heads(window_attention(wq_x, wk_x, wv_x, wk_c, wv_c, win_sink))
    gq_x = rope_axial(rmsnorm(split_heads(px[9], GLB_Q_HEADS), qn_g), ang_row, ang_col)
    gk_x = rope_axial(rmsnorm(split_heads(px[10], GLB_KV_HEADS), kn_g), ang_row, ang_col)
    gk_c = rmsnorm(split_heads(pc[10], GLB_KV_HEADS), kn_g)
    gv_c = split_heads(pc[11], GLB_KV_HEADS)
    k_all = jnp.concatenate([gk_c, gk_x], axis=2)
    v_all = jnp.concatenate([gv_c, split_heads(px[11], GLB_KV_HEADS)], axis=2)
    yc_x = merge_heads(global_attention(gq_x, k_all, v_all))
    out_x = merge_branches((ya_x, yb_x, yc_x), px[12], w_br, w_o)
    if not ctx_out:
        return out_x, None
    yb_c = merge_heads(ctx_attention(split_heads(pc[6], WIN_Q_HEADS), wk_c, wv_c, win_sink))
    yc_c = merge_heads(ctx_attention(rmsnorm(split_heads(pc[9], GLB_Q_HEADS), qn_g), gk_c, gv_c, None))
    out_c = merge_branches((ya_c, yb_c, yc_c), pc[12], w_br, w_o)
    return out_x, out_c


def swiglu(h, w1, w3, w2):
    return (jax.nn.silu(h @ w1) * (h @ w3)) @ w2


def setup_inputs(seed: int = 0) -> dict:
    key = jax.random.key(seed)
    ks = jax.random.split(key, 24)
    f32 = jnp.float32

    def lin(k, shape, fan_in):
        return jax.random.normal(k, shape, f32) * fan_in ** -0.5

    def gain(k, shape):
        return 1.0 + 0.05 * jax.random.normal(k, shape, f32)

    b_in = 0.02 * jax.random.normal(ks[8], (DEPTH, D_IN), f32)
    f_bias = 3.0 + 3.0 * jax.random.uniform(ks[9], (DEPTH, 2 * ML_HEADS), f32)
    b_in = b_in.at[:, ML_F_OFF:ML_F_OFF + 2 * ML_HEADS].set(f_bias)
    return {
        'x': jax.random.normal(ks[0], (BATCH, SEQ, D_MODEL), f32),
        'c': jax.random.normal(ks[1], (BATCH, D_MODEL), f32),
        'ctx': jax.random.normal(ks[2], (BATCH, CTX_LEN, D_MODEL), f32),
        'c_ctx': jax.random.normal(ks[3], (D_MODEL,), f32),
        'w_mod': lin(ks[4], (DEPTH, D_MODEL, 6 * D_MODEL), D_MODEL),
        'b_mod': 0.02 * jax.random.normal(ks[5], (DEPTH, 6 * D_MODEL), f32),
        'norm1_g': gain(ks[6], (DEPTH, D_MODEL)),
        'w_in': lin(ks[7], (DEPTH, D_MODEL, D_IN), D_MODEL),
        'b_in': b_in,
        'ml_norm_g': gain(ks[10], (DEPTH, ML_HEADS, ML_DIM)),
        'win_sink': jax.random.normal(ks[11], (DEPTH, WIN_Q_HEADS), f32),
        'qn_g': gain(ks[12], (DEPTH, HEAD_DIM)),
        'kn_g': gain(ks[13], (DEPTH, HEAD_DIM)),
        'w_br': lin(ks[14], (DEPTH, N_BRANCH, BRANCH_WIDTH, D_MODEL), BRANCH_WIDTH),
        'w_o': lin(ks[15], (DEPTH, D_MODEL, D_MODEL), D_MODEL),
        'norm2_g': gain(ks[16], (DEPTH, D_MODEL)),
        'w_ff1': lin(ks[17], (DEPTH, D_MODEL, D_FF), D_MODEL),
        'w_ff3': lin(ks[18], (DEPTH, D_MODEL, D_FF), D_MODEL),
        'w_ff2': lin(ks[19], (DEPTH, D_FF, D_MODEL), D_FF),
        'final_g': gain(ks[20], (D_MODEL,)),
    }


def reference(x, c, ctx, c_ctx, w_mod, b_mod, norm1_g, w_in, b_in, ml_norm_g, win_sink, qn_g, kn_g,
              w_br, w_o, norm2_g, w_ff1, w_ff3, w_ff2, final_g):
    ang_row, ang_col = axial_angles(x.shape[1])
    xc = ctx
    for l in range(DEPTH):
        ctx_out = l < DEPTH - 1
        mod_x = jnp.split((jax.nn.silu(c) @ w_mod[l] + b_mod[l])[:, None, :], 6, axis=-1)
        mod_c = jnp.split(jax.nn.silu(c_ctx) @ w_mod[l] + b_mod[l], 6, axis=-1)
        hx = modulate(rmsnorm(x, norm1_g[l]), mod_x[0], mod_x[1])
        hc = modulate(rmsnorm(xc, norm1_g[l]), mod_c[0], mod_c[1])
        out_x, out_c = token_mixers(hx, hc, w_in[l], b_in[l], ml_norm_g[l], win_sink[l], qn_g[l], kn_g[l],
                                    w_br[l], w_o[l], ang_row, ang_col, ctx_out)
        x = x + mod_x[2] * out_x
        hx = modulate(rmsnorm(x, norm2_g[l]), mod_x[3], mod_x[4])
        x = x + mod_x[5] * swiglu(hx, w_ff1[l], w_ff3[l], w_ff2[l])
        if ctx_out:
            xc = xc + mod_c[2] * out_c
            hc = modulate(rmsnorm(xc, norm2_g[l]), mod_c[3], mod_c[4])
            xc = xc + mod_c[5] * swiglu(hc, w_ff1[l], w_ff3[l], w_ff2[l])
    return rmsnorm(x, final_g)
```

```cpp
#include <hip/hip_runtime.h>
#include <hip/hip_bf16.h>
#include <cstdio>
#include <cstdint>
#include <cmath>
#ifndef MK_LAUNCH_PER_PHASE
#define MK_LAUNCH_PER_PHASE 0
#endif
constexpr int ROWS_CTX = 512, ROWS_LAT = 32768, ROWS = ROWS_CTX + ROWS_LAT;
#ifndef DBG_GAIN_MIX
#define DBG_GAIN_MIX 1.0f
#endif
#ifndef DBG_GAIN_FFN
#define DBG_GAIN_FFN 1.0f
#endif
#ifndef DBG_GAIN_BR0
#define DBG_GAIN_BR0 1.0f
#endif
#ifndef DBG_GAIN_BR1
#define DBG_GAIN_BR1 1.0f
#endif
#ifndef DBG_GAIN_BR2
#define DBG_GAIN_BR2 1.0f
#endif
#ifndef DBG_ML_SKIPDIR
#define DBG_ML_SKIPDIR -1
#endif
#ifndef DBG_ZERO
#define DBG_ZERO 0
#endif
#if defined(DBG_NAIVE)
#define DBG_NAIVE_BITS (DBG_NAIVE)
#else
#define DBG_NAIVE_BITS 0
#endif
#ifndef DBG_DUP
#define DBG_DUP 0
#endif
#ifndef DBG_BAR2
#define DBG_BAR2 0
#endif
#ifndef DBG_STG_MERGE
#define DBG_STG_MERGE 0
#endif
#ifndef DBG_STG_WO
#define DBG_STG_WO 0
#endif
#ifndef DBG_STG_FFN2
#define DBG_STG_FFN2 0
#endif
#ifndef DBG_STG_PROJ
#define DBG_STG_PROJ 0
#endif
#ifndef DBG_STG_GATES
#define DBG_STG_GATES 0
#endif
#ifndef DBG_STG_FFN1
#define DBG_STG_FFN1 0
#endif

namespace pg8 {
#define PG8_LAS __attribute__((address_space(3)))
typedef unsigned short bf16_t;
typedef short bf16x8 __attribute__((ext_vector_type(8)));
typedef float f32x4 __attribute__((ext_vector_type(4)));
typedef unsigned u32x4 __attribute__((ext_vector_type(4)));
constexpr int BM = 256, BK = 64, HALF = 128, HTB = HALF * BK * 2  , STAGE_BYTES = 8 * HTB, NXCD = 8, WGM = 8;

__host__ __device__ __forceinline__ int lds_byte(int r, int c) { const int st = (r >> 4) * 2 + (c >> 5), rr = r & 15, cc = c & 31, ob = rr * 64 + cc * 2; return st * 1024 + (ob ^ (((ob >> 9) & 1) << 5)); }
__host__ __device__ __forceinline__ void stage_rc(int b, int& R, int& C) { const int st = b / 1024, sb = b % 1024, swz = sb ^ (((sb >> 9) & 1) << 5); R = (st >> 1) * 16 + swz / 64; C = (st & 1) * 32 + (swz % 64) / 2; }
__host__ __device__ __forceinline__ int perm32(int rho) { const int n = rho >> 4, i = rho & 15; return 8 * (i >> 2) + 4 * n + (i & 3); }

struct Unit { int pm, pn, z; };
struct Gemm { const bf16_t* A; const bf16_t* Bt; int M, N, K; size_t zA, zB; };

struct StaticOrder {
    int nM, nN, nwg, G, c;
    __host__ __device__ void init(int M, int N, int G_, int c_) { nM = M / BM; nN = N / BM; nwg = nM * nN; G = G_; c = c_; }
    __host__ __device__ bool next(int i, Unit& u) const {
        const long L = (long)i * G + c; if (L >= nwg) return false;
        int wgid = (int)L; { const int q = nwg / NXCD, r = nwg % NXCD, xcd = wgid % NXCD, off = wgid / NXCD; wgid = (xcd < r ? xcd * (q + 1) : r * (q + 1) + (xcd - r) * q) + off; }
        const int nig = WGM * nN, gid = wgid / nig, fm = gid * WGM, gsz = (nM - fm) < WGM ? (nM - fm) : WGM;
        u.pm = fm + ((wgid % nig) % gsz); u.pn = (wgid % nig) / gsz; u.z = 0; return true;
    }
    __device__ __forceinline__ void a_ready(const Unit&) const {}
    __device__ __forceinline__ void done(const Unit&) const {}
};

struct TailOrder {
    int nN, nt, c0, c;
    __host__ __device__ void init(int M, int N, int c0_, int c_) { nN = N / BM; nt = (M / BM) * nN; c0 = c0_; c = c_; }
    __host__ __device__ bool next(int i, Unit& u) const { const int j = c - c0; if (i != 0 || j < 0 || j >= nt) return false; u.pm = j / nN; u.pn = j % nN; u.z = 0; return true; }
    __device__ __forceinline__ void a_ready(const Unit&) const {}
    __device__ __forceinline__ void done(const Unit&) const {}
};
template <int NZ> struct ZOrder {
    StaticOrder S;
    __host__ __device__ void init(int M, int N, int G_, int c_) { S.init(M, N, G_, c_); }
    __host__ __device__ bool next(int i, Unit& u) const { if (!S.next(i / NZ, u)) return false; u.z = i % NZ; return true; }
    __device__ __forceinline__ void a_ready(const Unit&) const {}
    __device__ __forceinline__ void done(const Unit&) const {}
};

typedef float f32x2c_t __attribute__((ext_vector_type(2))); typedef __bf16 bf16x2c_t __attribute__((ext_vector_type(2)));
__device__ __forceinline__ unsigned cvt_pk_bf16(float lo, float hi) { f32x2c_t v = {lo, hi}; bf16x2c_t b = __builtin_convertvector(v, bf16x2c_t); return __builtin_bit_cast(unsigned, b); }
typedef float f32x2 __attribute__((ext_vector_type(2)));

__device__ __forceinline__ float bf_lo(unsigned u) { return __uint_as_float(u << 16); }
__device__ __forceinline__ float bf_hi(unsigned u) { return __uint_as_float(u & 0xffff0000u); }
__device__ __forceinline__ float fast_sigmoid(float x) { return __builtin_amdgcn_rcpf(1.0f + __builtin_amdgcn_exp2f(-1.4426950408889634f * x)); }

struct EpiProj {
    static constexpr bool PERM = true, AFTER_DRAIN = false;
    bf16_t* base; const float* bias;
    __device__ __forceinline__ void operator()(const f32x4 (&acc)[2][2][4][2], const Unit& u, int wr, int wc, int fr, int fq) const {
        const int pn = u.pn; const size_t A512 = (size_t)ROWS * 512;
        size_t aoff; int ldc, colt;
        if (pn < 8)       { const int a = pn >> 1; aoff = (a == 0 ? 0 : (size_t)(a + 2) * A512); ldc = 512; colt = (pn & 1) * 256; }
        else if (pn < 10) { aoff = A512; ldc = 512; colt = (pn & 1) * 256; }
        else if (pn < 12) { aoff = 2 * A512; ldc = 512; colt = (pn & 1) * 256; }
        else if (pn == 12) { aoff = 6 * A512; ldc = 256; colt = 0; }
        else               { aoff = 6 * A512 + (size_t)ROWS * 256; ldc = 256; colt = 0; }
        bf16_t* dst = base + aoff;
        const int row0 = u.pm * BM + wr * 64 + fr, col0 = colt + wc * 32 + 8 * fq, bcol0 = pn * BM + wc * 32 + 8 * fq;
        f32x4 bv[2][2];
#pragma unroll
        for (int bj = 0; bj < 2; ++bj)
#pragma unroll
            for (int n = 0; n < 2; ++n) bv[bj][n] = *(const f32x4*)(bias + bcol0 + bj * HALF + 4 * n);
#pragma unroll
        for (int ai = 0; ai < 2; ++ai)
#pragma unroll
            for (int m = 0; m < 4; ++m) { bf16_t* rowp = dst + (size_t)(row0 + ai * HALF + m * 16) * ldc + col0;
#pragma unroll
                for (int bj = 0; bj < 2; ++bj) { const f32x4 v0 = acc[ai][bj][m][0] + bv[bj][0], v1 = acc[ai][bj][m][1] + bv[bj][1];
                    u32x4 w; w.x = cvt_pk_bf16(v0[0], v0[1]); w.y = cvt_pk_bf16(v0[2], v0[3]); w.z = cvt_pk_bf16(v1[0], v1[1]); w.w = cvt_pk_bf16(v1[2], v1[3]);
                    *(u32x4*)(rowp + bj * HALF) = w; } }
    }
};
struct EpiGate {
    static constexpr bool PERM = true, AFTER_DRAIN = false;
    bf16_t* O; int ldc; const float* bias; int r0;
    __device__ __forceinline__ void operator()(const f32x4 (&acc)[2][2][4][2], const Unit& u, int wr, int wc, int fr, int fq) const {
        const int row0 = r0 + u.pm * BM + wr * 64 + fr, col0 = u.pn * BM + wc * 32 + 8 * fq;
        f32x4 bv[2][2];
#pragma unroll
        for (int bj = 0; bj < 2; ++bj)
#pragma unroll
            for (int n = 0; n < 2; ++n) bv[bj][n] = *(const f32x4*)(bias + col0 + bj * HALF + 4 * n);
#pragma unroll
        for (int ai = 0; ai < 2; ++ai)
#pragma unroll
            for (int m = 0; m < 4; ++m) { bf16_t* rowp = O + (size_t)(row0 + ai * HALF + m * 16) * ldc + col0;
#pragma unroll
                for (int bj = 0; bj < 2; ++bj) { f32x4 v0 = acc[ai][bj][m][0] + bv[bj][0], v1 = acc[ai][bj][m][1] + bv[bj][1];
#pragma unroll
                    for (int e = 0; e < 4; ++e) { v0[e] = fast_sigmoid(v0[e]); v1[e] = fast_sigmoid(v1[e]); }
                    u32x4 w; w.x = cvt_pk_bf16(v0[0], v0[1]); w.y = cvt_pk_bf16(v0[2], v0[3]); w.z = cvt_pk_bf16(v1[0], v1[1]); w.w = cvt_pk_bf16(v1[2], v1[3]);
                    *(u32x4*)(rowp + bj * HALF) = w; } }
    }
};
template <bool FIRST_UNUSED> struct EpiMerge {
    static constexpr bool PERM = true, AFTER_DRAIN = false;
    const bf16_t* G0; const bf16_t* Gctx; int ldg; bf16_t* O; int r0; float gain; int pass;
    __device__ __forceinline__ void operator()(const f32x4 (&acc)[2][2][4][2], const Unit& u, int wr, int wc, int fr, int fq) const {
        const int row0 = r0 + u.pm * BM + wr * 64 + fr, col0 = u.pn * BM + wc * 32 + 8 * fq;
        const bf16_t* G = (r0 + u.pm * BM < ROWS_CTX) ? Gctx : G0; const bool FIRST = (pass == 0);
#pragma unroll
        for (int ai = 0; ai < 2; ++ai)
#pragma unroll
            for (int m = 0; m < 4; ++m) { const size_t row = (size_t)(row0 + ai * HALF + m * 16);
#pragma unroll
                for (int bj = 0; bj < 2; ++bj) {
                    const u32x4 g = *(const u32x4*)(G + row * ldg + col0 + bj * HALF);
                    f32x4 v0 = acc[ai][bj][m][0] * gain, v1 = acc[ai][bj][m][1] * gain;
                    v0[0] *= bf_lo(g.x); v0[1] *= bf_hi(g.x); v0[2] *= bf_lo(g.y); v0[3] *= bf_hi(g.y);
                    v1[0] *= bf_lo(g.z); v1[1] *= bf_hi(g.z); v1[2] *= bf_lo(g.w); v1[3] *= bf_hi(g.w);
                    bf16_t* op = O + row * 1024 + col0 + bj * HALF;
                    if (!FIRST) { const u32x4 p = *(const u32x4*)op;
                        v0[0] += bf_lo(p.x); v0[1] += bf_hi(p.x); v0[2] += bf_lo(p.y); v0[3] += bf_hi(p.y);
                        v1[0] += bf_lo(p.z); v1[1] += bf_hi(p.z); v1[2] += bf_lo(p.w); v1[3] += bf_hi(p.w); }
                    u32x4 w; w.x = cvt_pk_bf16(v0[0], v0[1]); w.y = cvt_pk_bf16(v0[2], v0[3]); w.z = cvt_pk_bf16(v1[0], v1[1]); w.w = cvt_pk_bf16(v1[2], v1[3]);
                    *(u32x4*)op = w; } }
    }
};
struct EpiResid {
    static constexpr bool PERM = false, AFTER_DRAIN = false;
    const float* old_ctx; const float* old_lat; float* new_ctx; float* new_lat; const float* mod;   int r0; float gain;
    __device__ __forceinline__ void operator()(const f32x4 (&acc)[2][2][4][2], const Unit& u, int wr, int wc, int fr, int fq) const {
        const int trow = r0 + u.pm * BM;
        const bool isctx = trow < ROWS_CTX; const int which = isctx ? 2 : ((trow - ROWS_CTX) >> 14);
        const float* xo = isctx ? old_ctx + (size_t)trow * 1024 : old_lat + (size_t)(trow - ROWS_CTX) * 1024;
        float* xn = isctx ? new_ctx + (size_t)trow * 1024 : new_lat + (size_t)(trow - ROWS_CTX) * 1024;
        const float* mv = mod + which * 6144;
        const int col0 = u.pn * BM + wc * 32 + 4 * fq;
        f32x4 mm[2][2];
#pragma unroll
        for (int bj = 0; bj < 2; ++bj)
#pragma unroll
            for (int n = 0; n < 2; ++n) mm[bj][n] = *(const f32x4*)(mv + col0 + bj * HALF + n * 16);
#pragma unroll
        for (int ai = 0; ai < 2; ++ai)
#pragma unroll
            for (int m = 0; m < 4; ++m) { const size_t off = (size_t)(ai * HALF + wr * 64 + m * 16 + fr) * 1024 + col0;
#pragma unroll
                for (int bj = 0; bj < 2; ++bj)
#pragma unroll
                    for (int n = 0; n < 2; ++n) { const f32x4 b = *(const f32x4*)(xo + off + bj * HALF + n * 16);
                        *(f32x4*)(xn + off + bj * HALF + n * 16) = b + mm[bj][n] * acc[ai][bj][m][n] * gain; } }
    }
};
struct EpiFFN1 {
    static constexpr bool PERM = true, AFTER_DRAIN = false;
    bf16_t* O; int r0;
    __device__ __forceinline__ void operator()(const f32x4 (&acc)[2][2][4][2], const Unit& u, int wr, int wc, int fr, int fq) const {
        const int row0 = r0 + u.pm * BM + wr * 64 + fr, col0 = u.pn * HALF + wc * 32 + 8 * fq;
#pragma unroll
        for (int ai = 0; ai < 2; ++ai)
#pragma unroll
            for (int m = 0; m < 4; ++m) { bf16_t* rowp = O + (size_t)(row0 + ai * HALF + m * 16) * 2816 + col0;
                f32x4 v0, v1;
#pragma unroll
                for (int e = 0; e < 4; ++e) { const float g0 = acc[ai][0][m][0][e], g1 = acc[ai][0][m][1][e];
                    v0[e] = g0 * fast_sigmoid(g0) * acc[ai][1][m][0][e]; v1[e] = g1 * fast_sigmoid(g1) * acc[ai][1][m][1][e]; }
                u32x4 w; w.x = cvt_pk_bf16(v0[0], v0[1]); w.y = cvt_pk_bf16(v0[2], v0[3]); w.z = cvt_pk_bf16(v1[0], v1[1]); w.w = cvt_pk_bf16(v1[2], v1[3]);
                *(u32x4*)rowp = w; }
    }
};

template <class Epi, class Sched, bool ALIGN_EPI = false, bool SP2 = false>
__device__ __forceinline__ void gemm_phase(PG8_LAS unsigned char* lds, const Gemm g, const Sched& S, const Epi& E) {
    const int tid = threadIdx.x, wid = __builtin_amdgcn_readfirstlane(tid >> 6), lane = tid & 63, wr = wid >> 2, wc = wid & 3, fr = lane & 15, fq = lane >> 4;
    const int K = g.K, nt = K / BK;
    unsigned voffA[2], voffB[2];
#pragma unroll
    for (int i = 0; i < 2; ++i) { int R, C; stage_rc(tid * 16 + i * 8192, R, C); const int Rb = Epi::PERM ? ((R & ~31) + perm32(R & 31)) : R;
        voffA[i] = (unsigned)(R * K + C) * 2u; voffB[i] = (unsigned)(Rb * K + C) * 2u; }
    const size_t kstep = (size_t)(BK * 2);
    const size_t hstep = (size_t)HALF * K * 2;
    const size_t tstep = 2 * hstep;
    const unsigned ldsw = (unsigned)wid * 1024u;
    const int aoff = lds_byte(wr * 64 + fr, fq * 8), boff = lds_byte(wc * 32 + fr, fq * 8);
#define PG8_SA(b, h) (((b) * 2 + (h)) * HTB)
#define PG8_SB(b, h) ((4 + (b) * 2 + (h)) * HTB)
#define PG8_STAGE(bufoff, gbase, voff) do { _Pragma("unroll") for (int _i = 0; _i < 2; ++_i) \
        __builtin_amdgcn_global_load_lds((const unsigned*)((const char*)(gbase) + (voff)[_i]), (PG8_LAS unsigned*)(lds + (bufoff) + ldsw + _i * 8192), 16, 0, 0); } while (0)
#define PG8_LDA(dst, b, h) do { _Pragma("unroll") for (int m = 0; m < 4; ++m) _Pragma("unroll") for (int k = 0; k < 2; ++k) dst[m][k] = *(const PG8_LAS bf16x8*)(lds + PG8_SA(b, h) + aoff + m * 2048 + k * 1024); } while (0)
#define PG8_LDB(dst, b, h) do { _Pragma("unroll") for (int n = 0; n < 2; ++n) _Pragma("unroll") for (int k = 0; k < 2; ++k) dst[n][k] = *(const PG8_LAS bf16x8*)(lds + PG8_SB(b, h) + boff + n * 2048 + k * 1024); } while (0)
#define PG8_MMA(ai, bj, At, Bt) do { __builtin_amdgcn_s_setprio(1); _Pragma("unroll") for (int m = 0; m < 4; ++m) _Pragma("unroll") for (int n = 0; n < 2; ++n) _Pragma("unroll") for (int k = 0; k < 2; ++k) \
        acc[ai][bj][m][n] = __builtin_amdgcn_mfma_f32_16x16x32_bf16(Bt[n][k], At[m][k], acc[ai][bj][m][n], 0, 0, 0); __builtin_amdgcn_s_setprio(0); } while (0)
#define PG8_WAIT_V(n) asm volatile("s_waitcnt vmcnt(" #n ")" ::: "memory")
#define PG8_WAIT_L(n) asm volatile("s_waitcnt lgkmcnt(" #n ")" ::: "memory")
#define PG8_BAR __builtin_amdgcn_s_barrier()
#define PG8_SCHED __builtin_amdgcn_sched_barrier(0)
    Unit cur, nxt; int ui = 0;
    if (!S.next(0, cur)) return;
    f32x4 acc[2][2][4][2];
#pragma unroll
    for (int a = 0; a < 2; ++a)
#pragma unroll
        for (int b = 0; b < 2; ++b)
#pragma unroll
            for (int m = 0; m < 4; ++m)
#pragma unroll
                for (int n = 0; n < 2; ++n) acc[a][b][m][n] = (f32x4){0.f, 0.f, 0.f, 0.f};
    bf16x8 At[4][2], B0[2][2], B1[2][2];
    const char* cA = (const char*)g.A + ((size_t)cur.z * g.zA) * 2 + (size_t)cur.pm * tstep; const char* cB = (const char*)g.Bt + ((size_t)cur.z * g.zB) * 2 + (size_t)cur.pn * tstep;
    S.a_ready(cur);
    if constexpr (SP2) {
        PG8_STAGE(PG8_SB(0, 0), cB, voffB); PG8_STAGE(PG8_SB(0, 1), cB + hstep, voffB); PG8_STAGE(PG8_SA(0, 0), cA, voffA); PG8_STAGE(PG8_SA(0, 1), cA + hstep, voffA);
        if (wr == 1) PG8_BAR;
        PG8_WAIT_V(2); PG8_BAR;
        PG8_STAGE(PG8_SB(1, 0), cB + kstep, voffB); PG8_STAGE(PG8_SA(1, 0), cA + kstep, voffA); PG8_STAGE(PG8_SB(1, 1), cB + hstep + kstep, voffB);
        PG8_WAIT_V(6); PG8_BAR;
    } else {
        PG8_STAGE(PG8_SB(0, 0), cB, voffB); PG8_STAGE(PG8_SA(0, 0), cA, voffA); PG8_STAGE(PG8_SB(0, 1), cB + hstep, voffB); PG8_STAGE(PG8_SA(0, 1), cA + hstep, voffA);
        if (wr == 1) PG8_BAR;
        PG8_WAIT_V(4); PG8_BAR;
        PG8_STAGE(PG8_SB(1, 0), cB + kstep, voffB); PG8_STAGE(PG8_SA(1, 0), cA + kstep, voffA); PG8_STAGE(PG8_SB(1, 1), cB + hstep + kstep, voffB);
        PG8_WAIT_V(6); PG8_BAR;
    }
    for (;;) {
        const bool has_next = S.next(ui + 1, nxt);
        const char* nA = has_next ? (const char*)g.A + ((size_t)nxt.z * g.zA) * 2 + (size_t)nxt.pm * tstep : cA; const char* nB = has_next ? (const char*)g.Bt + ((size_t)nxt.z * g.zB) * 2 + (size_t)nxt.pn * tstep : cB;
        for (int t = 0; t < nt; t += 2) {
            const bool last = (t == nt - 2);
            const char* a1 = cA + (size_t)(t + 1) * kstep;
            const char* a2 = last ? nA : cA + (size_t)(t + 2) * kstep; const char* b2 = last ? nB : cB + (size_t)(t + 2) * kstep;
            const char* a3 = a2 + kstep; const char* b3 = b2 + kstep;
            if (last && has_next) S.a_ready(nxt);
            if constexpr (SP2) {
            PG8_LDB(B0, 0, 0); PG8_LDB(B1, 0, 1); PG8_SCHED; PG8_LDA(At, 0, 0); PG8_STAGE(PG8_SA(1, 1), a1 + hstep, voffA);
            PG8_WAIT_V(8); PG8_WAIT_L(0); PG8_BAR; PG8_MMA(0, 0, At, B0); PG8_MMA(0, 1, At, B1); PG8_BAR; PG8_SCHED;
            PG8_LDA(At, 0, 1); PG8_STAGE(PG8_SB(0, 0), b2, voffB); PG8_STAGE(PG8_SB(0, 1), b2 + hstep, voffB); PG8_STAGE(PG8_SA(0, 0), a2, voffA);
            PG8_WAIT_V(8); PG8_WAIT_L(0); PG8_BAR; PG8_MMA(1, 0, At, B0); PG8_MMA(1, 1, At, B1); PG8_BAR; PG8_SCHED;
            PG8_LDB(B0, 1, 0); PG8_LDB(B1, 1, 1); PG8_SCHED; PG8_LDA(At, 1, 0); PG8_STAGE(PG8_SA(0, 1), a2 + hstep, voffA);
            PG8_WAIT_V(8); PG8_WAIT_L(0); PG8_BAR; PG8_MMA(0, 0, At, B0); PG8_MMA(0, 1, At, B1); PG8_BAR; PG8_SCHED;
            PG8_LDA(At, 1, 1); PG8_STAGE(PG8_SB(1, 0), b3, voffB); PG8_STAGE(PG8_SB(1, 1), b3 + hstep, voffB); PG8_STAGE(PG8_SA(1, 0), a3, voffA);
            PG8_WAIT_V(8); PG8_WAIT_L(0); PG8_BAR; PG8_MMA(1, 0, At, B0); PG8_MMA(1, 1, At, B1); PG8_BAR; PG8_SCHED;
            } else {
            PG8_LDB(B0, 0, 0); PG8_SCHED; PG8_LDA(At, 0, 0); PG8_STAGE(PG8_SA(1, 1), a1 + hstep, voffA);
            PG8_WAIT_L(8); PG8_BAR; PG8_WAIT_L(0); PG8_MMA(0, 0, At, B0); PG8_BAR; PG8_SCHED;
            PG8_LDB(B1, 0, 1); PG8_STAGE(PG8_SB(0, 0), b2, voffB);
            PG8_BAR; PG8_WAIT_L(0); PG8_MMA(0, 1, At, B1); PG8_BAR;
            PG8_LDA(At, 0, 1); PG8_STAGE(PG8_SA(0, 0), a2, voffA);
            PG8_BAR; PG8_WAIT_L(0); PG8_MMA(1, 0, At, B0); PG8_BAR; PG8_SCHED;
            PG8_STAGE(PG8_SB(0, 1), b2 + hstep, voffB);
            PG8_WAIT_V(6); PG8_BAR; PG8_MMA(1, 1, At, B1); PG8_BAR;
            PG8_LDB(B0, 1, 0); PG8_SCHED; PG8_LDA(At, 1, 0); PG8_STAGE(PG8_SA(0, 1), a2 + hstep, voffA);
            PG8_WAIT_L(8); PG8_BAR; PG8_WAIT_L(0); PG8_MMA(0, 0, At, B0); PG8_BAR; PG8_SCHED;
            PG8_LDB(B1, 1, 1); PG8_STAGE(PG8_SB(1, 0), b3, voffB);
            PG8_BAR; PG8_WAIT_L(0); PG8_MMA(0, 1, At, B1); PG8_BAR;
            PG8_LDA(At, 1, 1); PG8_STAGE(PG8_SA(1, 0), a3, voffA);
            PG8_BAR; PG8_WAIT_L(0); PG8_MMA(1, 0, At, B0); PG8_BAR; PG8_SCHED;
            PG8_STAGE(PG8_SB(1, 1), b3 + hstep, voffB);
            PG8_WAIT_V(6); PG8_BAR; PG8_MMA(1, 1, At, B1); PG8_BAR;
            }
        }
        if constexpr (ALIGN_EPI) { if (wr == 0) PG8_BAR; }
        if constexpr (!Epi::AFTER_DRAIN) { E(acc, cur, wr, wc, fr, fq); S.done(cur); }
        if (!has_next) break;
#pragma unroll
        for (int a = 0; a < 2; ++a)
#pragma unroll
            for (int b = 0; b < 2; ++b)
#pragma unroll
                for (int m = 0; m < 4; ++m)
#pragma unroll
                    for (int n = 0; n < 2; ++n) acc[a][b][m][n] = (f32x4){0.f, 0.f, 0.f, 0.f};
        cur = nxt; cA = nA; cB = nB; ++ui;
        if constexpr (ALIGN_EPI) { if (wr == 1) PG8_BAR; }
    }
    PG8_WAIT_V(0);
    if constexpr (!ALIGN_EPI) { if (wr == 0) PG8_BAR; }
    PG8_BAR;
    if constexpr (Epi::AFTER_DRAIN) { E.fused(acc, cur, wr, wc, fr, fq, lds, wid, lane); S.done(cur); }
#undef PG8_SA
#undef PG8_SB
#undef PG8_STAGE
#undef PG8_LDA
#undef PG8_LDB
#undef PG8_MMA
#undef PG8_WAIT_V
#undef PG8_WAIT_L
#undef PG8_BAR
#undef PG8_SCHED
}

}

namespace attn_body {
using bf16=__hip_bfloat16;
using bf16x8=__attribute__((ext_vector_type(8)))short;
using s16x4=__attribute__((ext_vector_type(4)))short;
using f32x16=__attribute__((ext_vector_type(16)))float;
using u32x4=__attribute__((ext_vector_type(4)))unsigned;
constexpr int SEQ=16384,D=64;
constexpr int NW=8,QBLK=32,QB=QBLK*NW,KVBLK=64;
constexpr int ATTN_UNIT_ROWS=QB;
__device__ __forceinline__ int crow(int r,int hi){return (r&3)+8*(r>>2)+4*hi;}
#define SBAR() __builtin_amdgcn_sched_barrier(0)
__device__ __forceinline__ float min3z(float a,float b){float r;asm("v_min3_f32 %0, %1, %2, 0":"=v"(r):"v"(a),"v"(b));return r;}
__device__ __forceinline__ void wmask(f32x16&p0,f32x16&p1,int klo,int khi,int hi){
  const float A=(float)(4*hi-klo), B=(float)(khi-4*hi);
  #pragma unroll
  for(int r=0;r<16;++r){const float c=(float)((r&3)+8*(r>>2));
    p0[r]=__builtin_fmaf(min3z(A+c,B-c),1e30f,p0[r]); p1[r]=__builtin_fmaf(min3z(A+(c+32.f),B-(c+32.f)),1e30f,p1[r]);}
}

constexpr int NSLOT=3, SLOTB=8192;
constexpr int LDS_K=0, LDS_V=NSLOT*SLOTB, LDS_WS=2*NSLOT*SLOTB, LDS_OST=LDS_WS+NW*64*4, LDS_BYTES=LDS_OST+NW*4096;
constexpr float C2=0.125f*1.4426950408889634f;
__device__ __forceinline__ void glds16(const void*gsrc,unsigned lds_dst){unsigned keep;
  asm volatile("s_mov_b32 %0, m0\n\ts_mov_b32 m0, %2\n\ts_nop 0\n\tglobal_load_lds_dwordx4 %1, off\n\ts_mov_b32 m0, %0":"=&s"(keep):"v"(gsrc),"s"(lds_dst):"memory");}
__device__ __forceinline__ float max3f(float a,float b,float c){float r;asm("v_max3_f32 %0, %1, %2, %3":"=v"(r):"v"(a),"v"(b),"v"(c));return r;}
__device__ __forceinline__ float max2f(float a,float b){float r;asm("v_max_f32_e32 %0, %1, %2":"=v"(r):"v"(a),"v"(b));return r;}
__device__ __forceinline__ float fadd_s(float a,float b){float r;asm("v_add_f32_e32 %0, %1, %2":"=v"(r):"v"(a),"v"(b));return r;}
__device__ __forceinline__ float fsub_s(float a,float b){float r;asm("v_sub_f32_e32 %0, %1, %2":"=v"(r):"v"(a),"v"(b));return r;}
typedef float f32x2_t __attribute__((ext_vector_type(2))); typedef __bf16 bf16x2_t __attribute__((ext_vector_type(2)));
__device__ __forceinline__ unsigned cvtpk_s(float lo,float hi){f32x2_t v={lo,hi};bf16x2_t b=__builtin_convertvector(v,bf16x2_t);return __builtin_bit_cast(unsigned,b);}
#define WAIT_BAR(N) asm volatile("s_waitcnt vmcnt(" #N ") lgkmcnt(0)\n\ts_barrier":::"memory")

__device__ __forceinline__ void qkt(f32x16&p0,f32x16&p1,const char*Kslot,const bf16x8*qr,const f32x16&negm,int r32,int hi){
  const char*kb=Kslot+hi*1024+r32*16;
  #pragma unroll
  for(int d0=0;d0<4;++d0){
    const bf16x8 b0=*reinterpret_cast<const bf16x8*>(kb+d0*2048);
    const bf16x8 b1=*reinterpret_cast<const bf16x8*>(kb+d0*2048+512);
    if(d0==0){p0=__builtin_amdgcn_mfma_f32_32x32x16_bf16(b0,qr[0],negm,0,0,0);p1=__builtin_amdgcn_mfma_f32_32x32x16_bf16(b1,qr[0],negm,0,0,0);}
    else{p0=__builtin_amdgcn_mfma_f32_32x32x16_bf16(b0,qr[d0],p0,0,0,0);p1=__builtin_amdgcn_mfma_f32_32x32x16_bf16(b1,qr[d0],p1,0,0,0);}}
}
typedef __attribute__((address_space(3))) const char* lds_cptr;
typedef short v4i16_t __attribute__((ext_vector_type(4)));
__device__ __forceinline__ void kload8(bf16x8*kf,lds_cptr kp){
  kf[0]=*(const __attribute__((address_space(3))) bf16x8*)(kp);      kf[1]=*(const __attribute__((address_space(3))) bf16x8*)(kp+512);
  kf[2]=*(const __attribute__((address_space(3))) bf16x8*)(kp+2048); kf[3]=*(const __attribute__((address_space(3))) bf16x8*)(kp+2560);
  kf[4]=*(const __attribute__((address_space(3))) bf16x8*)(kp+4096); kf[5]=*(const __attribute__((address_space(3))) bf16x8*)(kp+4608);
  kf[6]=*(const __attribute__((address_space(3))) bf16x8*)(kp+6144); kf[7]=*(const __attribute__((address_space(3))) bf16x8*)(kp+6656);
}
__device__ __forceinline__ void kload2(bf16x8*kf,lds_cptr kp,int j){ kf[2*j]=*(const __attribute__((address_space(3))) bf16x8*)(kp+j*2048); kf[2*j+1]=*(const __attribute__((address_space(3))) bf16x8*)(kp+j*2048+512); }
__device__ __forceinline__ s16x4 vtr(lds_cptr p){ return __builtin_bit_cast(s16x4,__builtin_amdgcn_ds_read_tr16_b64_v4i16((__attribute__((address_space(3))) v4i16_t*)p)); }
__device__ __forceinline__ float rowmax(const f32x16&p0,const f32x16&p1){
  float a=max3f(p0[0],p0[1],p1[0]),b=max3f(p0[2],p0[3],p1[1]);a=max3f(a,p1[2],p1[3]);
  #pragma unroll
  for(int r=4;r<16;r+=4){a=max3f(a,p0[r],p0[r+1]);b=max3f(b,p0[r+2],p0[r+3]);a=max3f(a,p1[r],p1[r+1]);b=max3f(b,p1[r+2],p1[r+3]);}
  const float m=max2f(a,b);
  auto rr=__builtin_amdgcn_permlane32_swap(__float_as_uint(m),__float_as_uint(m),false,false);
  return max2f(__uint_as_float(rr[0]),__uint_as_float(rr[1]));
}
__device__ __forceinline__ void pv(f32x16*o,int vb,bf16x8 pa0,bf16x8 pa1,bf16x8 pa2,bf16x8 pa3){
  #pragma unroll
  for(int d0=0;d0<2;++d0){s16x4 lo[4],hi[4];
    #pragma unroll
    for(int ks=0;ks<4;++ks){
      asm volatile("ds_read_b64_tr_b16 %0,%1 offset:%c2":"=&v"(lo[ks]):"v"(vb),"i"(d0*4096+ks*1024):"memory");
      asm volatile("ds_read_b64_tr_b16 %0,%1 offset:%c2":"=&v"(hi[ks]):"v"(vb),"i"(d0*4096+ks*1024+512):"memory");}
    asm volatile("s_waitcnt lgkmcnt(0)":::"memory");SBAR();
    #define PK(k) (bf16x8){lo[k][0],lo[k][1],lo[k][2],lo[k][3],hi[k][0],hi[k][1],hi[k][2],hi[k][3]}
    o[d0]=__builtin_amdgcn_mfma_f32_32x32x16_bf16(pa0,PK(0),o[d0],0,0,0);
    o[d0]=__builtin_amdgcn_mfma_f32_32x32x16_bf16(pa1,PK(1),o[d0],0,0,0);
    o[d0]=__builtin_amdgcn_mfma_f32_32x32x16_bf16(pa2,PK(2),o[d0],0,0,0);
    o[d0]=__builtin_amdgcn_mfma_f32_32x32x16_bf16(pa3,PK(3),o[d0],0,0,0);
    #undef PK
  }
}

#ifndef ATTN_STORE16
#define ATTN_STORE16(p,v) (*(u32x4*)(p)=(v))
#endif

struct AttnArgs { const bf16* Q; const bf16* K; const bf16* V; bf16* O; int pq, pkv; int qrow0; int ctxrow0, latrow0; int q0; float sink_l2; };
template<int MODE,int THRL> __device__ __forceinline__ void attn_unit(const AttnArgs&A,char*shm){
  constexpr int NT=(MODE==0||MODE==3)?260:(MODE==1)?12:4; constexpr bool PLAINC=(MODE==1||MODE==3);
  const bf16*Q=A.Q;const bf16*__restrict__ K=A.K;const bf16*__restrict__ V=A.V;bf16*O=A.O; const int PQ=A.pq,PKV=A.pkv;
  const int tid=threadIdx.x,lane=tid&63,r32=lane&31,hi=lane>>5; const int wid=__builtin_amdgcn_readfirstlane(tid>>6);
  const bf16*Qw=Q+(long)(A.qrow0+wid*QBLK)*PQ;
  const bf16*Kh=K,*Vh=V;
  const unsigned lds0=(unsigned)(uintptr_t)shm;
  float*wsf=(float*)(shm+LDS_WS)+wid*64;
  const bf16*ksrc=Kh+(long)lane*PKV+wid*8;
  const bf16*vsrc=Vh+(long)(16*(wid&3)+(lane>>2))*PKV+(wid>>2)*32+(lane&3)*8;
  const unsigned kdst=lds0+LDS_K+wid*1024, vdst=lds0+LDS_V+wid*1024;
  #define KROW(t) ( ((t)<4) ? (A.ctxrow0+64*(t)) : (MODE==1 ? (A.latrow0+min(max(A.q0-128+64*((t)-4),0),SEQ-64)) : (A.latrow0+64*((t)-4))) )
  #define DMA_K(t,slot) glds16(ksrc+(long)KROW(t)*PKV,(unsigned)__builtin_amdgcn_readfirstlane(kdst+(slot)))
  #define DMA_V(t,slot) glds16(vsrc+(long)KROW(t)*PKV,(unsigned)__builtin_amdgcn_readfirstlane(vdst+(slot)))
  const int vb0=(int)(lds0+LDS_V)+((lane>>4)&1)*32+(lane&3)*8+(4*hi+((lane&15)>>2))*64;
  const char*Kbase=shm+LDS_K; bf16x8 kf[8];
  const lds_cptr shm3=(lds_cptr)shm; const lds_cptr kp0=shm3+LDS_K+hi*1024+r32*16; const lds_cptr vp0=shm3+LDS_V+((lane>>4)&1)*32+(lane&3)*8+(4*hi+((lane&15)>>2))*64;
  DMA_K(0,0);DMA_V(0,0);DMA_K(1,SLOTB);
  bf16x8 qr[4];
  #pragma unroll
  for(int d0=0;d0<4;++d0)qr[d0]=*reinterpret_cast<const bf16x8*>(&Qw[(long)r32*PQ+d0*16+hi*8]);
  float mhat=0.f,l_reg=0.f;f32x16 o[2];o[0]=f32x16{};o[1]=f32x16{};f32x16 negm=f32x16{}; if(!PLAINC){asm volatile("":"+v"(negm));}
  const int qpos=A.q0+wid*QBLK+r32; const int kq_lo=max(qpos-128,0), kq_hi=min(qpos+128,SEQ-1);
  #define CMASK(P0,P1,t) do{ if(MODE==1){ if((t)>=4){ const int kb_=A.q0-128+64*((t)-4); int lo_=kq_lo-kb_,hi_=kq_hi-kb_; asm volatile("":"+v"(lo_),"+v"(hi_)); wmask(P0,P1,lo_,hi_,hi);} } }while(0)
  bool resc=false;
  #define START(P0,P1) do{ resc=false; \
    if(MODE!=3){ const float rm=rowmax(P0,P1); const float dl=rm; mhat=fadd_s(mhat,dl); \
      _Pragma("unroll") for(int r=0;r<16;++r){P0[r]=fsub_s(P0[r],dl);P1[r]=fsub_s(P1[r],dl);} \
      if(!PLAINC){ _Pragma("unroll") for(int r=0;r<16;++r)negm[r]=-mhat; asm volatile("":"+v"(negm)); } } \
    _Pragma("unroll") for(int r=0;r<16;++r)P0[r]=__builtin_amdgcn_exp2f(P0[r]); }while(0)
  #define RESC() do{ if(resc){ asm volatile("s_waitcnt lgkmcnt(0)":::"memory"); \
      _Pragma("unroll") for(int d_=0;d_<2;++d_) _Pragma("unroll") for(int r=0;r<16;++r)o[d_][r]*=wsf[crow(r,hi)]; } }while(0)
  f32x16 pA0,pA1,pB0,pB1;
  int sl_prev=0,sl_cur=0,sl_next=SLOTB;
  #define ROT() do{sl_prev=sl_cur;sl_cur=sl_next;sl_next=(sl_next==(NSLOT-1)*SLOTB)?0:sl_next+SLOTB;}while(0)
  DMA_K(2,2*SLOTB);
  WAIT_BAR(3);
  qkt(pA0,pA1,Kbase,qr,negm,r32,hi);asm volatile("s_nop 15\n\ts_nop 7":"+v"(pA0),"+v"(pA1));CMASK(pA0,pA1,0);
  START(pA0,pA1);
  _Pragma("unroll") for(int r=0;r<16;++r)pA1[r]=__builtin_amdgcn_exp2f(pA1[r]);
  WAIT_BAR(0);
  DMA_K(3,0);DMA_V(1,SLOTB);
  ROT();
  kload8(kf,kp0+sl_cur);
  WAIT_BAR(2);
  s16x4 vlo[8],vhi[8]; u32x4 pw0,pw1,pw2,pw3;
  #define PKW(P,B) cvtpk_s(P[B],P[B+1])
  #define PAF(k) __builtin_bit_cast(bf16x8,pw##k)
  #define VFR(i) (bf16x8){vlo[i][0],vlo[i][1],vlo[i][2],vlo[i][3],vhi[i][0],vhi[i][1],vhi[i][2],vhi[i][3]}
  #define PIN(x) asm volatile("":"+v"(x))
  #define MX3(a,b,c) __builtin_fmaxf(__builtin_fmaxf((a),(b)),(c))
  #define GAPA(MF,A0,A1,A2,A3,W0,W1,PW) do{ MF; sacc+=A0; sacc+=A1; sacc+=A2; sacc+=A3; PIN(sacc); W0; W1; PIN(PW); SBAR(); }while(0)
  #define EX(v) __builtin_amdgcn_exp2f(v)
  #define GAPB(MF,X,B) do{ MF; X[B]=EX(X[B]); X[B+1]=EX(X[B+1]); X[B+2]=EX(X[B+2]); X[B+3]=EX(X[B+3]); PIN(X); SBAR(); }while(0)
  #define VRD(i) do{ vlo[i]=vtr(vp_+(((i)>>2)*4096+((i)&3)*1024)); vhi[i]=vtr(vp_+(((i)>>2)*4096+((i)&3)*1024+512)); }while(0)
  #define KRD(G,j) do{ if(G){ kload2(kf,kp0+sl_next,j); SBAR(); } }while(0)
  #define STEP(C0,C1,P0,P1,t,GK,GV,GL) do{ SBAR(); \
    const lds_cptr vp_=vp0+sl_prev; \
    VRD(0); SBAR(); float sacc=(P0[0]+P0[1]); \
    GAPA(C0=__builtin_amdgcn_mfma_f32_32x32x16_bf16(kf[0],qr[0],negm,0,0,0), P0[2],P0[3],P0[4],P0[5],     pw0[0]=PKW(P0,0), pw0[1]=PKW(P0,2), pw0); \
    VRD(4); SBAR(); GAPA(C1=__builtin_amdgcn_mfma_f32_32x32x16_bf16(kf[1],qr[0],negm,0,0,0), P0[6],P0[7],P0[8],P0[9],     pw0[2]=PKW(P0,4), pw0[3]=PKW(P0,6), pw0); \
    VRD(1); SBAR(); GAPA(C0=__builtin_amdgcn_mfma_f32_32x32x16_bf16(kf[2],qr[1],C0,0,0,0),   P0[10],P0[11],P0[12],P0[13], pw1[0]=PKW(P0,8), pw1[1]=PKW(P0,10), pw1); \
    VRD(5); SBAR(); GAPA(C1=__builtin_amdgcn_mfma_f32_32x32x16_bf16(kf[3],qr[1],C1,0,0,0),   P0[14],P0[15],P1[0],P1[1],   pw1[2]=PKW(P0,12),pw1[3]=PKW(P0,14), pw1); \
    VRD(2); SBAR(); GAPA(C0=__builtin_amdgcn_mfma_f32_32x32x16_bf16(kf[4],qr[2],C0,0,0,0),   P1[2],P1[3],P1[4],P1[5],     pw2[0]=PKW(P1,0), pw2[1]=PKW(P1,2), pw2); \
    VRD(6); SBAR(); GAPA(C1=__builtin_amdgcn_mfma_f32_32x32x16_bf16(kf[5],qr[2],C1,0,0,0),   P1[6],P1[7],P1[8],P1[9],     pw2[2]=PKW(P1,4), pw2[3]=PKW(P1,6), pw2); \
    VRD(3); SBAR(); GAPA(C0=__builtin_amdgcn_mfma_f32_32x32x16_bf16(kf[6],qr[3],C0,0,0,0),   P1[10],P1[11],P1[12],P1[13], pw3[0]=PKW(P1,8), pw3[1]=PKW(P1,10), pw3); \
    VRD(7); SBAR(); GAPA(C1=__builtin_amdgcn_mfma_f32_32x32x16_bf16(kf[7],qr[3],C1,0,0,0),   P1[14],P1[15],0.f,0.f,       pw3[2]=PKW(P1,12),pw3[3]=PKW(P1,14), pw3); \
    l_reg+=sacc; \
    if(GK){DMA_K((t)+3,sl_cur);} if(GV){DMA_V((t)+1,sl_next);} \
    if(MODE==1){ _Pragma("unroll") for(int r=0;r<16;++r){C0[r]-=mhat;C1[r]-=mhat;} } \
    CMASK(C0,C1,t); \
    if(MODE!=3){ float a=MX3(C0[0],C0[1],C1[0]),b=MX3(C0[2],C0[3],C1[1]); a=MX3(a,C1[2],C1[3]); \
      _Pragma("unroll") for(int r=4;r<16;r+=4){a=MX3(a,C0[r],C0[r+1]);b=MX3(b,C0[r+2],C0[r+3]);a=MX3(a,C1[r],C1[r+1]);b=MX3(b,C1[r+2],C1[r+3]);} \
      float rm=__builtin_fmaxf(a,b); { auto rr=__builtin_amdgcn_permlane32_swap(__float_as_uint(rm),__float_as_uint(rm),false,false); rm=__builtin_fmaxf(__uint_as_float(rr[0]),__uint_as_float(rr[1])); } \
      resc=false; \
      if(__builtin_expect(__any(rm>(float)THRL),0)){ const float dl=__builtin_fmaxf(rm,0.f); mhat+=dl; \
        _Pragma("unroll") for(int r=0;r<16;++r){C0[r]-=dl;C1[r]-=dl;} \
        if(!PLAINC){ _Pragma("unroll") for(int r=0;r<16;++r)negm[r]=-mhat; asm volatile("":"+v"(negm)); } \
        const float f=__builtin_amdgcn_exp2f(-dl); l_reg*=f; if(hi==0)wsf[r32]=f; resc=true; } } \
    SBAR(); \
    GAPB(o[0]=__builtin_amdgcn_mfma_f32_32x32x16_bf16(PAF(0),VFR(0),o[0],0,0,0), C0,0); \
    GAPB(o[1]=__builtin_amdgcn_mfma_f32_32x32x16_bf16(PAF(0),VFR(4),o[1],0,0,0), C0,4); \
    KRD(GL,0); GAPB(o[0]=__builtin_amdgcn_mfma_f32_32x32x16_bf16(PAF(1),VFR(1),o[0],0,0,0), C0,8); \
    KRD(GL,1); GAPB(o[1]=__builtin_amdgcn_mfma_f32_32x32x16_bf16(PAF(1),VFR(5),o[1],0,0,0), C0,12); \
    KRD(GL,2); GAPB(o[0]=__builtin_amdgcn_mfma_f32_32x32x16_bf16(PAF(2),VFR(2),o[0],0,0,0), C1,0); \
    KRD(GL,3); GAPB(o[1]=__builtin_amdgcn_mfma_f32_32x32x16_bf16(PAF(2),VFR(6),o[1],0,0,0), C1,4); \
    GAPB(o[0]=__builtin_amdgcn_mfma_f32_32x32x16_bf16(PAF(3),VFR(3),o[0],0,0,0), C1,8); \
    GAPB(o[1]=__builtin_amdgcn_mfma_f32_32x32x16_bf16(PAF(3),VFR(7),o[1],0,0,0), C1,12); \
    }while(0)
  int t=1;
  for(;t+5<NT;t+=2){
    STEP(pB0,pB1,pA0,pA1,t,true,true,true);     WAIT_BAR(2); RESC(); ROT();
    STEP(pA0,pA1,pB0,pB1,t+1,true,true,true);   WAIT_BAR(2); RESC(); ROT();
  }
  #define ENDW(tt) do{ if((tt)+3<NT){WAIT_BAR(2);} else if((tt)+2<NT){WAIT_BAR(1);} else {WAIT_BAR(0);} }while(0)
  for(;t+1<NT;t+=2){
    STEP(pB0,pB1,pA0,pA1,t,(t+3<NT),(t+1<NT),(t+1<NT));       ENDW(t);   RESC(); ROT();
    STEP(pA0,pA1,pB0,pB1,t+1,(t+4<NT),(t+2<NT),(t+2<NT));     ENDW(t+1); RESC(); ROT();
  }
  STEP(pB0,pB1,pA0,pA1,NT-1,false,false,false); RESC();
  { float sacc=pB0[0]+pB0[1]; _Pragma("unroll") for(int r=2;r<16;++r)sacc+=pB0[r]; _Pragma("unroll") for(int r=0;r<16;++r)sacc+=pB1[r]; l_reg+=sacc;
    pw0=(u32x4){PKW(pB0,0),PKW(pB0,2),PKW(pB0,4),PKW(pB0,6)};pw1=(u32x4){PKW(pB0,8),PKW(pB0,10),PKW(pB0,12),PKW(pB0,14)};pw2=(u32x4){PKW(pB1,0),PKW(pB1,2),PKW(pB1,4),PKW(pB1,6)};pw3=(u32x4){PKW(pB1,8),PKW(pB1,10),PKW(pB1,12),PKW(pB1,14)};
    SBAR(); pv(o,vb0+sl_cur,PAF(0),PAF(1),PAF(2),PAF(3)); }
  #undef PKW
  #undef PAF
  #undef VFR
  #undef PIN
  #undef MX3
  #undef GAPA
  #undef GAPB
  #undef EX
  #undef VRD
  #undef KRD
  #undef STEP
  #undef ENDW
  {auto rr=__builtin_amdgcn_permlane32_swap(__float_as_uint(l_reg),__float_as_uint(l_reg),false,false);l_reg=__uint_as_float(rr[0])+__uint_as_float(rr[1]);}
  l_reg+=__builtin_amdgcn_exp2f(A.sink_l2-mhat);
  if(hi==0)wsf[32+r32]=l_reg;asm volatile("s_waitcnt lgkmcnt(0)":::"memory");
  float rli[16];
  #pragma unroll
  for(int r=0;r<16;++r)rli[r]=__builtin_amdgcn_rcpf(wsf[32+crow(r,hi)]);
  bf16*Ow=O+(long)(A.qrow0+wid*QBLK)*PQ;
  { bf16*stg=(bf16*)(shm+LDS_OST)+wid*2048;
    #pragma unroll
    for(int r=0;r<16;++r){const int orow=crow(r,hi);
      #pragma unroll
      for(int d0=0;d0<2;++d0)stg[orow*64+d0*32+r32]=__float2bfloat16(o[d0][r]*rli[r]);}
    asm volatile("s_waitcnt lgkmcnt(0)":::"memory");
    #pragma unroll
    for(int i=0;i<4;++i){const int row=i*8+(lane>>3),ch=lane&7; const u32x4 v=*(const u32x4*)(stg+row*64+ch*8); ATTN_STORE16(Ow+(long)row*PQ+ch*8,v);} }
  asm volatile("s_waitcnt lgkmcnt(0)\n\ts_barrier":::"memory");
  #undef DMA_K
  #undef KROW
  #undef DMA_V
  #undef CMASK
  #undef START
  #undef RESC
  #undef ROT
}
constexpr int ATTN_LDS_BYTES=LDS_BYTES;

#undef SBAR
#undef WAIT_BAR
}

constexpr int NWAVES = 8;
constexpr int DM = 1024, SEQ = 16384, DIN = 6672, DFF = 2816, NPROJ = 3584, NGATE = 3072;
constexpr int NCHUNK = 130;
constexpr float NORM_EPS = 1e-6f;
constexpr int N_PHASES = 24;
constexpr size_t MiB = 1u << 20;
constexpr size_t WS_CTL = 0, CTL_ZERO_BYTES = 1 * MiB;
constexpr size_t WS_SMALL = 1 * MiB;
constexpr int SM_MODV = 0, SM_ROPE = 36864, SM_BIASP = 47104, SM_BIASG = 50688, SM_SC = 53760, SM_MB = 57920, SM_BIAS1 = 60000;
constexpr size_t WS_XC = 2 * MiB, WS_GATESF = 4 * MiB, WS_W = 8 * MiB, WS_HX = 44 * MiB, WS_PROJ = 110 * MiB, WS_ST = 338 * MiB, WS_MERGED = 406 * MiB, WS_W2 = 472 * MiB, WS_GSCTX = 507 * MiB, WS_END = 510 * MiB;
constexpr size_t A512 = (size_t)ROWS * 512;
constexpr size_t PJ_MLQ = 0, PJ_WQ = A512, PJ_GQ = 2 * A512, PJ_MLK = 3 * A512, PJ_MLV = 4 * A512, PJ_MLO = 5 * A512, PJ_WKV = 6 * A512, PJ_GKV = 6 * A512 + (size_t)ROWS * 256;
constexpr size_t W_P = 0, W_G = (size_t)NPROJ * 1024, W_BR = W_G + (size_t)NGATE * 1024, W_O = W_BR + (size_t)3 * 1024 * 512, W_13 = W_O + (size_t)1024 * 1024, W_2 = W_13 + (size_t)5632 * 1024;
constexpr int ST_ROWS = 132, ST_SLOT = ST_ROWS * 128;
static_assert(WS_W + (W_2 + (size_t)1024 * DFF) * 2 <= WS_HX && WS_HX + (size_t)ROWS * 1024 * 2 <= WS_PROJ && WS_PROJ + (PJ_GKV + (size_t)ROWS * 256) * 2 <= WS_ST, "ws map 1");
static_assert(WS_ST + (size_t)16 * NCHUNK * ST_SLOT * 2 <= WS_MERGED && WS_MERGED + (size_t)ROWS * 1024 * 2 <= WS_END, "ws map 2");
static_assert(WS_PROJ + PJ_MLK * 2 + (size_t)ROWS * NGATE * 2 <= WS_MERGED && (size_t)ROWS * DFF * 2 <= (WS_ST - WS_PROJ), "overlays");
constexpr int CW_BAR = 4096;
constexpr int RING_BYTES = 131072, MISC_OFF = 147456 - 128, LDS_BYTES = 147456;

#define GAS __attribute__((address_space(1)))
#define LAS __attribute__((address_space(3)))
typedef unsigned short bf16;
typedef unsigned v4u __attribute__((ext_vector_type(4)));
typedef unsigned v2u __attribute__((ext_vector_type(2)));
typedef float f32x4 __attribute__((ext_vector_type(4)));
typedef float f32x16 __attribute__((ext_vector_type(16)));
typedef short bf16x8 __attribute__((ext_vector_type(8)));
typedef short s16x4 __attribute__((ext_vector_type(4)));
typedef GAS unsigned gu32;
#define LDS_WAIT() asm volatile("s_waitcnt lgkmcnt(0)" ::: "memory")
#define VM_WAIT() asm volatile("s_waitcnt vmcnt(0)" ::: "memory")
__device__ __forceinline__ unsigned f2bf(float f) { unsigned u = __builtin_bit_cast(unsigned, f); return (u + 0x7fffu + ((u >> 16) & 1u)) >> 16; }
__device__ __forceinline__ unsigned pk2(float lo, float hi) { return f2bf(lo) | (f2bf(hi) << 16); }
__device__ __forceinline__ float bf2f(unsigned short h) { return __uint_as_float((unsigned)h << 16); }

#define XB_TMO      128
#define XB_XCNT(j)  (256  + 64 * (j))
#define XB_XSUB(j)  (1280 + 64 * (j))
#define XB_XGEN(j)  (2304 + 64 * (j))
#define XB_TOP      3328
#define XB_TOPGEN   3392
#define XCD_BAR_WORDS 3456
#define XB_SPIN_CAP (1u << 18)

__device__ __forceinline__ unsigned xb_ld(unsigned* p)              { return __hip_atomic_load(p, __ATOMIC_RELAXED, __HIP_MEMORY_SCOPE_AGENT); }
__device__ __forceinline__ unsigned xb_add(unsigned* p, unsigned v) { return __hip_atomic_fetch_add(p, v, __ATOMIC_RELAXED, __HIP_MEMORY_SCOPE_AGENT); }
__device__ __forceinline__ unsigned xb_xcc_id() { return (unsigned)__builtin_amdgcn_s_getreg((3 << 11) | 20) & 0xFu; }
#define XB_SPIN(cond, bar) do { unsigned _sp = 0; while (cond) { __builtin_amdgcn_s_sleep(1); \
    if ((++_sp & 255u) == 0u) { if (xb_ld(&(bar)[XB_TMO])) break; if (_sp > XB_SPIN_CAP) { atomicAdd(&(bar)[XB_TMO], 1u); break; } } } } while (0)

struct XcdBarrier {
    unsigned* bar; unsigned x;
    volatile LAS unsigned* st;
};

__device__ __forceinline__ XcdBarrier xcd_barrier_post(unsigned* bar, volatile LAS unsigned* st) {
    XcdBarrier b; b.bar = bar; b.x = xb_xcc_id(); b.st = st;
    if (threadIdx.x == 0) (void)xb_add(&bar[XB_XCNT(b.x)], 1u);
    return b;
}
__device__ __forceinline__ void xcd_barrier_complete(unsigned* bar, unsigned x, unsigned& nloc, unsigned& nx) {
    const unsigned G = gridDim.x * gridDim.y * gridDim.z;
    unsigned sum, cnt, mine, sp = 0u;
    for (;;) {
        sum = 0u; cnt = 0u; mine = 0u;
#pragma unroll
        for (unsigned j = 0; j < 16; ++j) { const unsigned c = xb_ld(&bar[XB_XCNT(j)]); sum += c; cnt += (c > 0u) ? 1u : 0u; mine = (j == x) ? c : mine; }
        if (sum == G) break;
        __builtin_amdgcn_s_sleep(1);
        if ((++sp & 255u) == 0u) { if (xb_ld(&bar[XB_TMO])) break; if (sp > XB_SPIN_CAP) { atomicAdd(&bar[XB_TMO], 1u); break; } }
    }
    nloc = mine > 0u ? mine : 1u; nx = cnt > 0u ? cnt : 1u;
}

__device__ __forceinline__ void xcd_barrier(const XcdBarrier& b) {
    asm volatile("s_waitcnt vmcnt(0)" ::: "memory");
    __syncthreads();
    if (threadIdx.x == 0) {
        unsigned* bar = b.bar;
        __builtin_amdgcn_s_waitcnt(0);
        unsigned nloc = b.st[0], nx = b.st[1];
        if (nloc == 0u) { xcd_barrier_complete(bar, b.x, nloc, nx); b.st[0] = nloc; b.st[1] = nx; }
        const unsigned old = xb_add(&bar[XB_XSUB(b.x)], 1u);
        const unsigned gen = old / nloc;
        if (old + 1u == (gen + 1u) * nloc) {
            __builtin_amdgcn_fence(__ATOMIC_RELEASE, "agent");
            asm volatile("s_waitcnt vmcnt(0)" ::: "memory");
            const unsigned og = xb_add(&bar[XB_TOP], 1u);
            const unsigned tg = og / nx;
            if (og + 1u == (tg + 1u) * nx) xb_add(&bar[XB_TOPGEN], 1u);
            else XB_SPIN(xb_ld(&bar[XB_TOPGEN]) == tg, bar);
            __builtin_amdgcn_fence(__ATOMIC_ACQUIRE, "agent");
            xb_add(&bar[XB_XGEN(b.x)], 1u);
            asm volatile("s_waitcnt vmcnt(0)" ::: "memory");
        } else {
            XB_SPIN(xb_ld(&bar[XB_XGEN(b.x)]) == gen, bar);
            __builtin_amdgcn_fence(__ATOMIC_ACQUIRE, "agent");
            asm volatile("s_waitcnt vmcnt(0)" ::: "memory");
        }
    }
    __syncthreads();
}


struct Args { const float* in[20]; float* out; unsigned char* ws; int ph_lo, ph_hi; };
struct Frame {
    const Args& A;
    LAS unsigned char* lds;
    volatile LAS unsigned* MISC;
    int tid, wave, vcu, G;
    __device__ __forceinline__ int lane() const { return tid & 63; }
#define FIN(name, idx) __device__ __forceinline__ const float* name() const { return A.in[idx]; }
    FIN(x, 0) FIN(c, 1) FIN(ctx, 2) FIN(c_ctx, 3) FIN(w_mod, 4) FIN(b_mod, 5) FIN(norm1_g, 6) FIN(w_in, 7) FIN(b_in, 8) FIN(ml_norm_g, 9) FIN(win_sink, 10) FIN(qn_g, 11) FIN(kn_g, 12)
    FIN(w_br, 13) FIN(w_o, 14) FIN(norm2_g, 15) FIN(w_ff1, 16) FIN(w_ff3, 17) FIN(w_ff2, 18) FIN(final_g, 19)
#undef FIN
    __device__ __forceinline__ float* out() const { return A.out; }
    __device__ __forceinline__ gu32* ctl() const { return (gu32*)(A.ws + WS_CTL); }
    __device__ __forceinline__ float* small() const { return (float*)(A.ws + WS_SMALL); }
    __device__ __forceinline__ float* xc() const { return (float*)(A.ws + WS_XC); }
    __device__ __forceinline__ float* gatesf() const { return (float*)(A.ws + WS_GATESF); }
    __device__ __forceinline__ bf16* W(int l) const { return (bf16*)(A.ws + (l ? WS_W2 : WS_W)); }
    __device__ __forceinline__ const float* biasP(int l) const { return small() + (l ? SM_BIAS1 : SM_BIASP); }
    __device__ __forceinline__ const float* biasG(int l) const { return small() + (l ? SM_BIAS1 + NPROJ : SM_BIASG); }
    __device__ __forceinline__ bf16* HX() const { return (bf16*)(A.ws + WS_HX); }
    __device__ __forceinline__ bf16* PROJ() const { return (bf16*)(A.ws + WS_PROJ); }
    __device__ __forceinline__ bf16* ST() const { return (bf16*)(A.ws + WS_ST); }
    __device__ __forceinline__ bf16* MERGED() const { return (bf16*)(A.ws + WS_MERGED); }
    __device__ __forceinline__ bf16* GSCTX() const { return (bf16*)(A.ws + WS_GSCTX); }
};
__device__ __forceinline__ float wave_sum(float v) {
#pragma unroll
    for (int o = 1; o < 64; o <<= 1) v += __shfl_xor(v, o);
    return v;
}
__device__ __forceinline__ void transpose_item(const float* W, int ldw, int srccol0, int K, bf16* WT, int dstrow0, int kb, LAS float* scr, int lane) {
    const int k0 = 64 * kb;
#pragma unroll 8
    for (int i = 0; i < 32; ++i) { const int kk = 2 * i + (lane >> 5); scr[kk * 33 + (lane & 31)] = W[(size_t)(k0 + kk) * ldw + srccol0 + (lane & 31)]; }
    LDS_WAIT(); asm volatile("" ::: "memory");
    const int c = lane & 7;
#pragma unroll
    for (int j = 0; j < 4; ++j) { const int n = (lane >> 3) + 8 * j; const LAS float* s = scr + (8 * c) * 33 + n;
        v4u o; o.x = pk2(s[0 * 33], s[1 * 33]); o.y = pk2(s[2 * 33], s[3 * 33]); o.z = pk2(s[4 * 33], s[5 * 33]); o.w = pk2(s[6 * 33], s[7 * 33]);
        *(GAS v4u*)(WT + (size_t)(dstrow0 + n) * K + k0 + 8 * c) = o; }
    LDS_WAIT(); asm volatile("" ::: "memory");
}
__device__ __forceinline__ void conv_weights(Frame& F, int l) {
    LAS float* scr = (LAS float*)(F.lds + F.wave * 16384);
    const int gw = F.vcu * NWAVES + F.wave, NGW = F.G * NWAVES;
    const float* w_in = F.w_in() + (size_t)l * 1024 * DIN;
    constexpr int I_P = 16 * 112, I_G = 16 * 96, I_BR = 3 * 8 * 32, I_O = 16 * 32, I_1 = 16 * 88, I_2 = 44 * 32;
    constexpr int NITEMS = I_P + I_G + I_BR + I_O + 2 * I_1 + I_2;
    for (int it = gw; it < NITEMS; it += NGW) {
        int r = it;
        if (r < I_P) { const int kb = r / 112, n0 = (r % 112) * 32;
            const int sc = n0 < 2048 ? n0 : n0 < 2560 ? 2064 + (n0 - 2048) : n0 < 3072 ? 2832 + (n0 - 2560) : n0 < 3328 ? 2576 + (n0 - 3072) : 3344 + (n0 - 3328);
            transpose_item(w_in, DIN, sc, 1024, F.W(l) + W_P, n0, kb, scr, F.lane()); continue; } r -= I_P;
        if (r < I_G) { const int kb = r / 96, n0 = (r % 96) * 32; transpose_item(w_in, DIN, 3600 + n0, 1024, F.W(l) + W_G, n0, kb, scr, F.lane()); continue; } r -= I_G;
        if (r < I_BR) { const int br = r / 256, rr = r % 256, kb = rr / 32, n0 = (rr % 32) * 32;
            transpose_item(F.w_br() + (size_t)(l * 3 + br) * 512 * 1024, 1024, n0, 512, F.W(l) + W_BR + (size_t)br * 1024 * 512, n0, kb, scr, F.lane()); continue; } r -= I_BR;
        if (r < I_O) { const int kb = r / 32, n0 = (r % 32) * 32; transpose_item(F.w_o() + (size_t)l * 1024 * 1024, 1024, n0, 1024, F.W(l) + W_O, n0, kb, scr, F.lane()); continue; } r -= I_O;
        if (r < I_1) { const int kb = r / 88, n0 = (r % 88) * 32; transpose_item(F.w_ff1() + (size_t)l * 1024 * DFF, DFF, n0, 1024, F.W(l) + W_13, (n0 / 128) * 256 + (n0 % 128), kb, scr, F.lane()); continue; } r -= I_1;
        if (r < I_1) { const int kb = r / 88, n0 = (r % 88) * 32; transpose_item(F.w_ff3() + (size_t)l * 1024 * DFF, DFF, n0, 1024, F.W(l) + W_13, (n0 / 128) * 256 + 128 + (n0 % 128), kb, scr, F.lane()); continue; } r -= I_1;
        { const int kb = r / 32, n0 = (r % 32) * 32; transpose_item(F.w_ff2() + (size_t)l * DFF * 1024, 1024, n0, DFF, F.W(l) + W_2, n0, kb, scr, F.lane()); }
    }
    const float* b_in = F.b_in() + (size_t)l * DIN;
    for (int i = F.vcu * 512 + F.tid; i < NPROJ + NGATE; i += F.G * 512) {
        if (i < NPROJ) { const int n0 = i; const int sc = n0 < 2048 ? n0 : n0 < 2560 ? 2064 + (n0 - 2048) : n0 < 3072 ? 2832 + (n0 - 2560) : n0 < 3328 ? 2576 + (n0 - 3072) : 3344 + (n0 - 3328);
            F.small()[(l ? SM_BIAS1 : SM_BIASP) + i] = b_in[sc]; }
        else F.small()[(l ? SM_BIAS1 + NPROJ : SM_BIASG) + (i - NPROJ)] = b_in[3600 + (i - NPROJ)];
    }
}
__device__ __forceinline__ void ph_prologue(Frame& F) {
    if (F.vcu < 192) {
        const int l = F.vcu / 96, jb = F.vcu % 96;
        LAS float* sl = (LAS float*)F.lds;
        LAS float* red = sl + 3072;
        for (int i = F.tid; i < 3072; i += 512) { const int w = i >> 10, k = i & 1023; const float v = w < 2 ? F.c()[w * 1024 + k] : F.c_ctx()[k]; sl[i] = v / (1.0f + expf(-v)); }
        __syncthreads();
        const float* W = F.w_mod() + (size_t)l * 1024 * 6144 + jb * 64 + F.lane();
        float a0 = 0.f, a1 = 0.f, a2 = 0.f;
        const int kbeg = 128 * F.wave;
#pragma unroll 16
        for (int k = kbeg; k < kbeg + 128; ++k) { const float w = W[(size_t)k * 6144]; a0 += w * sl[k]; a1 += w * sl[1024 + k]; a2 += w * sl[2048 + k]; }
        red[(F.wave * 3 + 0) * 64 + F.lane()] = a0; red[(F.wave * 3 + 1) * 64 + F.lane()] = a1; red[(F.wave * 3 + 2) * 64 + F.lane()] = a2;
        __syncthreads();
        if (F.tid < 192) { const int w = F.tid >> 6, col = F.tid & 63; float sacc = 0.f;
#pragma unroll
            for (int q = 0; q < 8; ++q) sacc += red[(q * 3 + w) * 64 + col];
            F.small()[SM_MODV + (l * 3 + w) * 6144 + jb * 64 + col] = sacc + F.b_mod()[l * 6144 + jb * 64 + col]; }
        __syncthreads();
    } else if (F.vcu == 192) {
        for (int i = F.tid; i < 5120; i += 512) { const bool isrow = i < 4096; const int j = isrow ? i : i - 4096; const int pos = j >> 4, fi = j & 15;
            const float inv = (float)pow(10000.0, -(double)(2 * fi) / 32.0); const float ang = (float)pos * inv;
            const float cs = (float)cos((double)ang), sn = (float)sin((double)ang);
            if (isrow) { F.small()[SM_ROPE + j] = cs; F.small()[SM_ROPE + 4096 + j] = sn; } else { F.small()[SM_ROPE + 8192 + j] = cs; F.small()[SM_ROPE + 8192 + 1024 + j] = sn; } }
    }
    conv_weights(F, 0);
    conv_weights(F, 1);
}
template <int WHICH> __device__ __forceinline__ void ph_norm(Frame& F, int l, int row_lo) {
    LAS float* wg = (LAS float*)F.lds;
    if (WHICH == 0) {
        __syncthreads();
        const float* w_in = F.w_in() + (size_t)l * 1024 * DIN + 2048;
        for (int i = F.tid; i < 16384; i += 512) { const int k = i >> 4, cc = i & 15; wg[cc * 1028 + k] = w_in[(size_t)k * DIN + cc]; }
        __syncthreads();
    }
    const float* gain = (WHICH == 0 ? F.norm1_g() : F.norm2_g()) + l * 1024;
    const float* modl = F.small() + SM_MODV + l * 3 * 6144;
    const int gw = F.vcu * NWAVES + F.wave, NGW = F.G * NWAVES;
    const int lane = F.lane();
    const bool srcin = (WHICH == 0 && l == 0);
    const float* src_ctx = srcin ? F.ctx() : F.xc(); const float* src_lat = srcin ? F.x() : F.out();
#define NORM_ROWPTR(r_) ((r_) < ROWS_CTX ? src_ctx + (size_t)(r_) * 1024 : src_lat + (size_t)((r_) - ROWS_CTX) * 1024)
    f32x4 gn[4];
#pragma unroll
    for (int j = 0; j < 4; ++j) gn[j] = *(const f32x4*)(gain + 4 * lane + 256 * j);
    int row = row_lo + gw;
    f32x4 v[4], vn[4];
    if (row < ROWS) { const float* xr = NORM_ROWPTR(row);
#pragma unroll
        for (int j = 0; j < 4; ++j) v[j] = *(const f32x4*)(xr + 4 * lane + 256 * j); }
    for (; row < ROWS; row += NGW) {
        const int nrow = row + NGW;
        if (nrow < ROWS) { const float* xn = NORM_ROWPTR(nrow);
#pragma unroll
            for (int j = 0; j < 4; ++j) vn[j] = *(const f32x4*)(xn + 4 * lane + 256 * j); }
        const bool isctx = row < ROWS_CTX; const int which = isctx ? 2 : ((row - ROWS_CTX) >> 14);
        const float* sh = modl + which * 6144 + (WHICH == 0 ? 0 : 3072); const float* sc = sh + 1024;
        float ss = 0.f;
#pragma unroll
        for (int j = 0; j < 4; ++j) ss += (v[j].x * v[j].x + v[j].y * v[j].y) + (v[j].z * v[j].z + v[j].w * v[j].w);
        const float rstd = 1.0f / sqrtf(wave_sum(ss) * (1.0f / 1024.0f) + NORM_EPS);
        bf16* orow = F.HX() + (size_t)row * 1024;
#pragma unroll
        for (int j = 0; j < 4; ++j) { const int c0 = 4 * lane + 256 * j; const f32x4 s1 = *(const f32x4*)(sc + c0), s0 = *(const f32x4*)(sh + c0);
            v[j] = (v[j] * rstd * gn[j]) * (s1 + 1.0f) + s0;
            v2u o; o.x = pk2(v[j].x, v[j].y); o.y = pk2(v[j].z, v[j].w); *(GAS v2u*)(orow + c0) = o; }
        if (WHICH == 0) {
            float p[16];
#pragma unroll
            for (int cc = 0; cc < 16; ++cc) { float a = 0.f;
                if ((cc & 1) == 0) __builtin_amdgcn_sched_barrier(0);
#pragma unroll
                for (int j = 0; j < 4; ++j) { const f32x4 w = *(const LAS f32x4*)(wg + cc * 1028 + 4 * lane + 256 * j); a += (v[j].x * w.x + v[j].y * w.y) + (v[j].z * w.z + v[j].w * w.w); }
                p[cc] = a; }
            __builtin_amdgcn_sched_barrier(0);
            const bool b5 = lane & 32, b4 = lane & 16, b3 = lane & 8, b2 = lane & 4;
            float q8[8], q4[4], q2[2], q1;
#pragma unroll
            for (int i = 0; i < 8; ++i) { const float mine = b5 ? p[i + 8] : p[i], give = b5 ? p[i] : p[i + 8]; q8[i] = mine + __shfl_xor(give, 32); }
#pragma unroll
            for (int i = 0; i < 4; ++i) { const float mine = b4 ? q8[i + 4] : q8[i], give = b4 ? q8[i] : q8[i + 4]; q4[i] = mine + __shfl_xor(give, 16); }
#pragma unroll
            for (int i = 0; i < 2; ++i) { const float mine = b3 ? q4[i + 2] : q4[i], give = b3 ? q4[i] : q4[i + 2]; q2[i] = mine + __shfl_xor(give, 8); }
            { const float mine = b2 ? q2[1] : q2[0], give = b2 ? q2[0] : q2[1]; q1 = mine + __shfl_xor(give, 4); }
            q1 += __shfl_xor(q1, 1); q1 += __shfl_xor(q1, 2);
            const int oc = (b5 ? 8 : 0) + (b4 ? 4 : 0) + (b3 ? 2 : 0) + (b2 ? 1 : 0);
            if ((lane & 3) == 0) F.gatesf()[(size_t)row * 16 + oc] = q1 + F.b_in()[(size_t)l * DIN + 2048 + oc];
        }
#pragma unroll
        for (int j = 0; j < 4; ++j) v[j] = vn[j];
    }
#undef NORM_ROWPTR
    if (WHICH == 0) __syncthreads();
}
__device__ __forceinline__ void ph_rope(Frame& F, int l) {
    const int gw = F.vcu * NWAVES + F.wave, NGW = F.G * NWAVES;
    int lane_ = F.lane(); asm volatile("" : "+v"(lane_)); const int lane = lane_;
    const int c = lane & 7; const bool second = c & 2;
    const float* qn = F.qn_g() + l * 64; const float* kn = F.kn_g() + l * 64;
    const float C2 = 0.125f * 1.4426950408889634f;
    const float* rope = F.small() + SM_ROPE;
    for (int row = gw; row < ROWS; row += NGW) {
        const bool lat = row >= ROWS_CTX; const int t = (row - ROWS_CTX) & (SEQ - 1);
        f32x4 cs0 = {1.f, 1.f, 1.f, 1.f}, cs1 = cs0, sn0 = {0.f, 0.f, 0.f, 0.f}, sn1 = sn0;
        if (lat) { const int pos = (c & 4) ? (t & 63) : (t >> 6); const float* tb = rope + ((c & 4) ? 8192 : 0) + pos * 16 + 8 * (c & 1); const int so = (c & 4) ? 1024 : 4096;
            cs0 = *(const f32x4*)tb; cs1 = *(const f32x4*)(tb + 4); sn0 = *(const f32x4*)(tb + so); sn1 = *(const f32x4*)(tb + so + 4); }
        bf16* p[3]; bool donorm[3]; float scale[3]; const float* gn[3];
        p[0] = F.PROJ() + PJ_WQ + (size_t)row * 512 + lane * 8; donorm[0] = false; scale[0] = C2; gn[0] = qn;
        p[1] = F.PROJ() + PJ_GQ + (size_t)row * 512 + lane * 8; donorm[1] = true; scale[1] = C2; gn[1] = qn;
        p[2] = (lane < 16) ? F.PROJ() + PJ_WKV + (size_t)row * 256 + lane * 8 : F.PROJ() + PJ_GKV + (size_t)row * 256 + (lane & 15) * 8; donorm[2] = lane >= 16; scale[2] = 1.0f; gn[2] = kn;
        v4u x[3];
#pragma unroll
        for (int g = 0; g < 3; ++g) x[g] = (g < 2 || lane < 32) ? *(const GAS v4u*)p[g] : (v4u){0u, 0u, 0u, 0u};
#pragma unroll
        for (int g = 0; g < 3; ++g) {
            float e[8]; e[0] = __uint_as_float(x[g].x << 16); e[1] = __uint_as_float(x[g].x & 0xffff0000u); e[2] = __uint_as_float(x[g].y << 16); e[3] = __uint_as_float(x[g].y & 0xffff0000u);
            e[4] = __uint_as_float(x[g].z << 16); e[5] = __uint_as_float(x[g].z & 0xffff0000u); e[6] = __uint_as_float(x[g].w << 16); e[7] = __uint_as_float(x[g].w & 0xffff0000u);
            float ss = 0.f;
#pragma unroll
            for (int i = 0; i < 8; ++i) ss += e[i] * e[i];
            ss += __shfl_xor(ss, 1); ss += __shfl_xor(ss, 2); ss += __shfl_xor(ss, 4);
            if (donorm[g]) { const float r = 1.0f / sqrtf(ss * (1.0f / 64.0f) + NORM_EPS); const f32x4 g0 = *(const f32x4*)(gn[g] + 8 * c), g1 = *(const f32x4*)(gn[g] + 8 * c + 4);
                e[0] *= r * g0.x; e[1] *= r * g0.y; e[2] *= r * g0.z; e[3] *= r * g0.w; e[4] *= r * g1.x; e[5] *= r * g1.y; e[6] *= r * g1.z; e[7] *= r * g1.w; }
            float o[8];
#pragma unroll
            for (int i = 0; i < 8; ++i) { const float pr = __shfl_xor(e[i], 2); const float cs = i < 4 ? cs0[i & 3] : cs1[i & 3], sn = i < 4 ? sn0[i & 3] : sn1[i & 3];
                o[i] = (second ? (pr * sn + e[i] * cs) : (e[i] * cs - pr * sn)) * scale[g]; }
            v4u w; w.x = pk2(o[0], o[1]); w.y = pk2(o[2], o[3]); w.z = pk2(o[4], o[5]); w.w = pk2(o[6], o[7]);
            if (g < 2 || lane < 32) *(GAS v4u*)p[g] = w;
        }
    }
}

__device__ __forceinline__ float log_sigmoid_f(float x) { return fminf(x, 0.f) - log1pf(expf(-fabsf(x))); }
__device__ __forceinline__ int crow16(int r, int hi) { return (r & 3) + 8 * (r >> 2) + 4 * hi; }
__device__ __forceinline__ s16x4 tr_read(const LAS unsigned char* p) {
    typedef short v4i16_t __attribute__((ext_vector_type(4)));
    return __builtin_bit_cast(s16x4, __builtin_amdgcn_ds_read_tr16_b64_v4i16((LAS v4i16_t*)p));
}
__device__ __forceinline__ bf16x8 cat8(s16x4 lo, s16x4 hi) { return (bf16x8){lo[0], lo[1], lo[2], lo[3], hi[0], hi[1], hi[2], hi[3]}; }
__device__ __forceinline__ unsigned scale_pk(unsigned u, float w) { return pk2(__uint_as_float(u << 16) * w, __uint_as_float(u & 0xffff0000u) * w); }
__device__ __forceinline__ int chunk_row0(int b, int cidx) { return cidx < 2 ? b * 256 + cidx * 128 : ROWS_CTX + b * SEQ + (cidx - 2) * 128; }
__device__ __forceinline__ int chain_order(int dir, int j) { return dir == 0 ? j : (j < 2 ? 1 - j : 131 - j); }
template <bool OUT> __device__ __forceinline__ void ml_gates(const float* gatesf, int row0, int dir, int h, float m_before, LAS float* A0, LAS float* A1, LAS float* A2, LAS float* A3, int lane, float& b_end, float& G_end) {
    const int tA = dir ? 127 - lane : lane, tB = dir ? 63 - lane : 64 + lane;
    const float iA = gatesf[(size_t)(row0 + tA) * 16 + dir * 4 + h], fA = gatesf[(size_t)(row0 + tA) * 16 + 8 + dir * 4 + h];
    const float iB = gatesf[(size_t)(row0 + tB) * 16 + dir * 4 + h], fB = gatesf[(size_t)(row0 + tB) * 16 + 8 + dir * 4 + h];
    float sA = log_sigmoid_f(fA), sB = log_sigmoid_f(fB);
#pragma unroll
    for (int o = 1; o < 64; o <<= 1) { const float a = __shfl_up(sA, o), b = __shfl_up(sB, o); if (lane >= o) { sA += a; sB += b; } }
    sB += __shfl(sA, 63);
    const float gA = iA - sA, gB = iB - sB;
    float mA = gA, mB = gB;
#pragma unroll
    for (int o = 1; o < 64; o <<= 1) { const float a = __shfl_up(mA, o), b = __shfl_up(mB, o); if (lane >= o) { mA = fmaxf(mA, a); mB = fmaxf(mB, b); } }
    mB = fmaxf(mB, __shfl(mA, 63));
    b_end = __shfl(sB, 63); G_end = __shfl(mB, 63);
    if (!OUT) { A0[tA] = expf(gA - G_end); A0[tB] = expf(gB - G_end); }
    else { const float qscale = 0.08838834764831845f;
        const float muA = fmaxf(m_before, mA), muB = fmaxf(m_before, mB);
        A0[tA] = gA; A1[tA] = muA; A2[tA] = expf(m_before - muA) * qscale; A3[tA] = expf(-(sA + muA));
        A0[tB] = gB; A1[tB] = muB; A2[tB] = expf(m_before - muB) * qscale; A3[tB] = expf(-(sB + muB)); }
}
__device__ __forceinline__ void ml_local_unit(Frame& F, int b, int dir, int h, int cidx) {
    LAS unsigned char* Kt = F.lds; LAS unsigned char* Vx = F.lds + 40960; LAS float* wk = (LAS float*)(F.lds + 81920);
    const int row0 = chunk_row0(b, cidx), chain = (b * 2 + dir) * 4 + h;
    const int lane = F.lane(), r32 = lane & 31, hi = lane >> 5;
    if (F.wave == 0) { float be, ge; ml_gates<false>(F.gatesf(), row0, dir, h, 0.f, wk, wk, wk, wk, lane, be, ge);
        if (lane == 0) { F.small()[SM_SC + (chain * NCHUNK + cidx) * 2] = be; F.small()[SM_SC + (chain * NCHUNK + cidx) * 2 + 1] = ge; } }
    __syncthreads();
    const bf16* mlk = F.PROJ() + PJ_MLK + (size_t)row0 * 512 + h * 128; const bf16* mlv = F.PROJ() + PJ_MLV + (size_t)row0 * 512 + h * 128;
#pragma unroll
    for (int i = 0; i < 4; ++i) { const int id = F.tid + 512 * i, row = id >> 4, ch = id & 15;
        v4u kv = *(const GAS v4u*)(mlk + (size_t)row * 512 + ch * 8); const float w = wk[row];
        kv.x = scale_pk(kv.x, w); kv.y = scale_pk(kv.y, w); kv.z = scale_pk(kv.z, w); kv.w = scale_pk(kv.w, w);
        *(LAS v4u*)(Kt + row * 320 + ch * 16) = kv;
        *(LAS v4u*)(Vx + row * 320 + ch * 16) = *(const GAS v4u*)(mlv + (size_t)row * 512 + ch * 8); }
    if (F.tid < 128) { LAS v4u* p = (LAS v4u*)(Vx + F.tid * 320 + 256); p[0] = (v4u){0x00003F80u, 0u, 0u, 0u}; p[1] = (v4u){0u, 0u, 0u, 0u}; p[2] = p[1]; p[3] = p[1]; }
    __syncthreads();
    const int dkt = F.wave & 3, half = F.wave >> 2;
    const int g = (lane >> 4) & 1, q = (lane & 15) >> 2, p4 = lane & 3;
    const LAS unsigned char* kbase = Kt + (8 * hi + q) * 320 + (dkt * 32 + 16 * g + 4 * p4) * 2;
    const LAS unsigned char* vbase = Vx + (8 * hi + q) * 320 + (16 * g + 4 * p4) * 2;
    f32x16 acc0 = {}, acc1 = {}, acc2 = {};
    const int dv0 = half ? 2 : 0;
#pragma unroll
    for (int ks = 0; ks < 8; ++ks) {
        const bf16x8 Bf = cat8(tr_read(kbase + ks * 16 * 320), tr_read(kbase + ks * 16 * 320 + 4 * 320));
        const bf16x8 A0 = cat8(tr_read(vbase + ks * 16 * 320 + dv0 * 64), tr_read(vbase + ks * 16 * 320 + 4 * 320 + dv0 * 64));
        const bf16x8 A1 = cat8(tr_read(vbase + ks * 16 * 320 + (dv0 + 1) * 64), tr_read(vbase + ks * 16 * 320 + 4 * 320 + (dv0 + 1) * 64));
        acc0 = __builtin_amdgcn_mfma_f32_32x32x16_bf16(A0, Bf, acc0, 0, 0, 0);
        acc1 = __builtin_amdgcn_mfma_f32_32x32x16_bf16(A1, Bf, acc1, 0, 0, 0);
        if (half == 0) { const bf16x8 A2 = cat8(tr_read(vbase + ks * 16 * 320 + 4 * 64), tr_read(vbase + ks * 16 * 320 + 4 * 320 + 4 * 64));
            acc2 = __builtin_amdgcn_mfma_f32_32x32x16_bf16(A2, Bf, acc2, 0, 0, 0); }
    }
    bf16* slot = F.ST() + (size_t)(chain * NCHUNK + cidx) * ST_SLOT + dkt * 32 + r32;
#pragma unroll
    for (int r = 0; r < 16; ++r) { const int dr = crow16(r, hi);
        slot[(size_t)(dv0 * 32 + dr) * 128] = (bf16)f2bf(acc0[r]); slot[(size_t)((dv0 + 1) * 32 + dr) * 128] = (bf16)f2bf(acc1[r]); }
    if (half == 0 && hi == 0) slot[(size_t)128 * 128] = (bf16)f2bf(acc2[0]);
    __syncthreads();
}
__device__ __forceinline__ void ph_scan(Frame& F, const bool dummy) {
    LAS float* cA = (LAS float*)F.lds; LAS float* cB = cA + 132; LAS float* cM = cB + 132; LAS float* sc = cM + 132;
    for (int item = F.vcu; item < 256; item += F.G) {
        const int chain = item >> 4, part = item & 15, dir = (chain >> 2) & 1;
        __syncthreads();
        if (F.tid < 2 * NCHUNK) sc[F.tid] = F.small()[SM_SC + chain * 2 * NCHUNK + F.tid];
        __syncthreads();
        if (F.tid == 0) { float m = 0.f;
            for (int j = 0; j < NCHUNK; ++j) { const int s = chain_order(dir, j); const float be = sc[2 * s], ge = sc[2 * s + 1], mx = fmaxf(m, ge);
                cA[j] = expf(m - mx); cB[j] = expf(ge - mx); cM[j] = m; m = be + mx; } }
        __syncthreads();
        if (part == 0 && F.tid < NCHUNK) F.small()[SM_MB + chain * NCHUNK + chain_order(dir, F.tid)] = cM[F.tid];
        bf16* base = F.ST() + (size_t)chain * NCHUNK * ST_SLOT; bf16* wbase = dummy ? F.MERGED() + (size_t)(chain & 1) * NCHUNK * ST_SLOT : base;
        const int off = (8 * part + (F.tid >> 6)) * 128 + 2 * (F.tid & 63), offx = 128 * 128 + 2 * (F.tid & 63);
        const bool hasx = (part == 0) && (F.wave == 0);
        float s0 = 0.f, s1 = 0.f, x0 = 0.f, x1 = 0.f;
        unsigned q[8], qx[8];
#pragma unroll
        for (int k = 0; k < 8; ++k) { q[k] = *(const GAS unsigned*)(base + (size_t)chain_order(dir, k) * ST_SLOT + off); qx[k] = hasx ? *(const GAS unsigned*)(base + (size_t)chain_order(dir, k) * ST_SLOT + offx) : 0u; }
        for (int j0 = 0; j0 < NCHUNK; j0 += 8) {
#pragma unroll
            for (int k = 0; k < 8; ++k) { const int j = j0 + k;
                if (j < NCHUNK) {
                    const unsigned cur = q[k], curx = qx[k]; const size_t so = (size_t)chain_order(dir, j) * ST_SLOT;
                    if (j + 8 < NCHUNK) { const size_t sn = (size_t)chain_order(dir, j + 8) * ST_SLOT; q[k] = *(const GAS unsigned*)(base + sn + off); if (hasx) qx[k] = *(const GAS unsigned*)(base + sn + offx); }
                    const float a = cA[j], bb = cB[j];
                    *(GAS unsigned*)(wbase + so + off) = pk2(s0, s1);
                    s0 = a * s0 + bb * __uint_as_float(cur << 16); s1 = a * s1 + bb * __uint_as_float(cur & 0xffff0000u);
                    if (hasx) { *(GAS unsigned*)(wbase + so + offx) = pk2(x0, x1); x0 = a * x0 + bb * __uint_as_float(curx << 16); x1 = a * x1 + bb * __uint_as_float(curx & 0xffff0000u); }
                } }
        }
    }
}
__device__ __forceinline__ void ml_out_unit(Frame& F, int l, int b, int h, int cidx, bf16* ybase) {
    LAS unsigned char* Kt = F.lds;
    LAS unsigned char* Vx = F.lds + 34816;
    LAS unsigned char* Ct = F.lds + 75776;
    LAS float* hs = (LAS float*)(F.lds + 75776);
    LAS float* scal = (LAS float*)(F.lds + 141824);
    constexpr int CT_DIR = 129 * 256, CT_CHUNKS = 129 * 16;
    const int row0 = chunk_row0(b, cidx);
    int tid_ = F.tid; asm volatile("" : "+v"(tid_));
    const int tid = tid_, lane = tid & 63, r32 = lane & 31, hi = lane >> 5;
    const int tt = F.wave & 3, dir = F.wave >> 2, tl = tt * 32 + r32;
    const bf16* mlk = F.PROJ() + PJ_MLK + (size_t)row0 * 512 + h * 128; const bf16* mlv = F.PROJ() + PJ_MLV + (size_t)row0 * 512 + h * 128;
    const bf16* mlq = F.PROJ() + PJ_MLQ + (size_t)row0 * 512 + h * 128; bf16* yq = ybase + (size_t)row0 * 512 + h * 128; const bf16* mlo = F.PROJ() + PJ_MLO + (size_t)row0 * 512 + h * 128;
    v4u kr[4], vr[4], cr[9], qu[8];
#pragma unroll
    for (int i = 0; i < 4; ++i) { const int id = tid + 512 * i, row = id >> 4, ch = id & 15; kr[i] = *(const GAS v4u*)(mlk + (size_t)row * 512 + ch * 8); vr[i] = *(const GAS v4u*)(mlv + (size_t)row * 512 + ch * 8); }
#pragma unroll
    for (int i = 0; i < 9; ++i) { const int c = tid + 512 * i;
        if (i < 8 || tid < 2 * CT_CHUNKS - 4096) { const int d = c >= CT_CHUNKS ? 1 : 0, rem = c - d * CT_CHUNKS, row = rem >> 4, ch = rem & 15;
            cr[i] = *(const GAS v4u*)(F.ST() + (size_t)(((b * 2 + d) * 4 + h) * NCHUNK + cidx) * ST_SLOT + (size_t)row * 128 + ch * 8); } else cr[i] = (v4u){0u, 0u, 0u, 0u}; }
#pragma unroll
    for (int ks = 0; ks < 8; ++ks) qu[ks] = *(const GAS v4u*)(mlq + (size_t)tl * 512 + ks * 16 + hi * 8);
    if (F.wave < 2) { const int d = F.wave, chain = (b * 2 + d) * 4 + h; const float mb = F.small()[SM_MB + chain * NCHUNK + cidx]; float be, ge; LAS float* S = scal + d * 512;
        ml_gates<true>(F.gatesf(), row0, d, h, mb, S, S + 128, S + 256, S + 384, lane, be, ge); }
#pragma unroll
    for (int i = 0; i < 4; ++i) { const int id = tid + 512 * i, row = id >> 4, ch = id & 15; *(LAS v4u*)(Kt + row * 272 + ch * 16) = kr[i]; *(LAS v4u*)(Vx + row * 320 + ch * 16) = vr[i]; }
    if (tid < 128) { LAS v4u* p = (LAS v4u*)(Vx + tid * 320 + 256); v4u one = (v4u){0x00003F80u, 0u, 0u, 0u}, zz = (v4u){0u, 0u, 0u, 0u}; asm volatile("" : "+v"(one), "+v"(zz)); p[0] = one; p[1] = zz; p[2] = zz; p[3] = zz; }
#pragma unroll
    for (int i = 0; i < 9; ++i) { const int c = tid + 512 * i;
        if (i < 8 || tid < 2 * CT_CHUNKS - 4096) { const int d = c >= CT_CHUNKS ? 1 : 0, rem = c - d * CT_CHUNKS, row = rem >> 4, ch = rem & 15;
            *(LAS v4u*)(Ct + d * CT_DIR + row * 256 + ((ch ^ (row & 15)) << 4)) = cr[i]; } }
    __syncthreads();
    unsigned hpk[4][8];
    {
        const LAS float* Sg = scal + dir * 512; const LAS float* Smu = Sg + 128; const LAS float* Sa = Sg + 256; const LAS float* Sfl = Sg + 384;
        const float mu_t = Smu[tl];
        const float qscale = 0.08838834764831845f;
        bf16x8 pa[4][2];
#pragma unroll
        for (int st = 0; st < 4; ++st) {
            const bool valid = dir == 0 ? (st <= tt) : (st >= tt);
            if (valid) {
                f32x16 acc = {};
#pragma unroll
                for (int ks = 0; ks < 8; ++ks) { const bf16x8 kf = *(const LAS bf16x8*)(Kt + (st * 32 + r32) * 272 + (ks * 16 + hi * 8) * 2); acc = __builtin_amdgcn_mfma_f32_32x32x16_bf16(kf, __builtin_bit_cast(bf16x8, qu[ks]), acc, 0, 0, 0); }
                float pv[16];
#pragma unroll
                for (int r = 0; r < 16; ++r) { const int s = st * 32 + crow16(r, hi); const float w = __builtin_amdgcn_exp2f((Sg[s] - mu_t) * 1.4426950408889634f); const bool ok = dir == 0 ? (s <= tl) : (s >= tl); pv[r] = ok ? acc[r] * qscale * w : 0.f; }
                v4u p0, p1; p0.x = pk2(pv[0], pv[1]); p0.y = pk2(pv[2], pv[3]); p0.z = pk2(pv[4], pv[5]); p0.w = pk2(pv[6], pv[7]);
                p1.x = pk2(pv[8], pv[9]); p1.y = pk2(pv[10], pv[11]); p1.z = pk2(pv[12], pv[13]); p1.w = pk2(pv[14], pv[15]);
                pa[st][0] = __builtin_bit_cast(bf16x8, p0); pa[st][1] = __builtin_bit_cast(bf16x8, p1);
            } else { pa[st][0] = (bf16x8){0, 0, 0, 0, 0, 0, 0, 0}; pa[st][1] = pa[st][0]; }
        }
        const int g = (lane >> 4) & 1, q = (lane & 15) >> 2, p4 = lane & 3;
        const LAS unsigned char* vbase = Vx + (4 * hi + q) * 320 + (16 * g + 4 * p4) * 2;
        const LAS unsigned char* cdir = Ct + dir * CT_DIR;
        float inv[16], arow[16];
#pragma unroll
        for (int r = 0; r < 16; ++r) arow[r] = Sa[tt * 32 + crow16(r, hi)];
#pragma unroll
        for (int di = 0; di < 5; ++di) { const int dvt = di == 0 ? 4 : di - 1;
            __builtin_amdgcn_sched_barrier(0);
            f32x16 acc = {};
#pragma unroll
            for (int st = 0; st < 4; ++st) { const bool valid = dir == 0 ? (st <= tt) : (st >= tt);
                if (valid) {
#pragma unroll
                    for (int k2 = 0; k2 < 2; ++k2) { const int sb = st * 32 + 16 * k2;
                        const bf16x8 Bf = cat8(tr_read(vbase + sb * 320 + dvt * 64), tr_read(vbase + (sb + 8) * 320 + dvt * 64));
                        acc = __builtin_amdgcn_mfma_f32_32x32x16_bf16(pa[st][k2], Bf, acc, 0, 0, 0); } } }
            const int dvr = min(dvt * 32 + r32, 128), sw = dvr & 15; const LAS unsigned char* crow_p = cdir + dvr * 256;
            f32x16 acc2 = {};
#pragma unroll
            for (int ks = 0; ks < 8; ++ks) { const bf16x8 Bf = *(const LAS bf16x8*)(crow_p + (((2 * ks + hi) ^ sw) << 4)); acc2 = __builtin_amdgcn_mfma_f32_32x32x16_bf16(__builtin_bit_cast(bf16x8, qu[ks]), Bf, acc2, 0, 0, 0); }
            if (di == 0) {
#pragma unroll
                for (int r = 0; r < 16; ++r) { const int tr = tt * 32 + crow16(r, hi); const float den = __shfl(acc[r] + arow[r] * acc2[r], lane & 32); inv[r] = __builtin_amdgcn_rcpf(fmaxf(fabsf(den), Sfl[tr])); }
            } else {
#pragma unroll
                for (int r = 0; r < 16; r += 2) hpk[di - 1][r >> 1] = pk2((acc[r] + arow[r] * acc2[r]) * inv[r], (acc[r + 1] + arow[r + 1] * acc2[r + 1]) * inv[r + 1]);
            }
        }
    }
    __syncthreads();
    const int frow = tid >> 2, fqd = tid & 3;
    v4u og[4];
#pragma unroll
    for (int c = 0; c < 4; ++c) og[c] = *(const GAS v4u*)(mlo + (size_t)frow * 512 + fqd * 32 + 8 * c);
    if (dir == 0) {
#pragma unroll
        for (int dt = 0; dt < 4; ++dt)
#pragma unroll
            for (int r = 0; r < 16; ++r) hs[(tt * 32 + crow16(r, hi)) * 128 + dt * 32 + r32] = (r & 1) ? __uint_as_float(hpk[dt][r >> 1] & 0xffff0000u) : __uint_as_float(hpk[dt][r >> 1] << 16);
    }
    __syncthreads();
    if (dir == 1) {
#pragma unroll
        for (int dt = 0; dt < 4; ++dt)
#pragma unroll
            for (int r = 0; r < 16; ++r) hs[(tt * 32 + crow16(r, hi)) * 128 + dt * 32 + r32] += (r & 1) ? __uint_as_float(hpk[dt][r >> 1] & 0xffff0000u) : __uint_as_float(hpk[dt][r >> 1] << 16);
    }
    __syncthreads();
    {
        const float* gn = F.ml_norm_g() + (size_t)(l * 4 + h) * 128;
        const LAS f32x4* hp = (const LAS f32x4*)(hs + frow * 128 + fqd * 32);
        f32x4 hv[8]; float ss = 0.f;
#pragma unroll
        for (int j = 0; j < 8; ++j) { hv[j] = hp[j]; ss += (hv[j].x * hv[j].x + hv[j].y * hv[j].y) + (hv[j].z * hv[j].z + hv[j].w * hv[j].w); }
        ss += __shfl_xor(ss, 1); ss += __shfl_xor(ss, 2);
        const float r = 1.0f / sqrtf(ss * (1.0f / 128.0f) + NORM_EPS);
        GAS v4u* yp = (GAS v4u*)(yq + (size_t)frow * 512 + fqd * 32);
#pragma unroll
        for (int c = 0; c < 4; ++c) { const v4u ou = og[c]; const f32x4 ga = *(const f32x4*)(gn + fqd * 32 + 8 * c), gb = *(const f32x4*)(gn + fqd * 32 + 8 * c + 4);
            const f32x4 a = hv[2 * c], bq = hv[2 * c + 1]; v4u o;
            o.x = pk2(a.x * r * ga.x * pg8::fast_sigmoid(__uint_as_float(ou.x << 16)), a.y * r * ga.y * pg8::fast_sigmoid(__uint_as_float(ou.x & 0xffff0000u)));
            o.y = pk2(a.z * r * ga.z * pg8::fast_sigmoid(__uint_as_float(ou.y << 16)), a.w * r * ga.w * pg8::fast_sigmoid(__uint_as_float(ou.y & 0xffff0000u)));
            o.z = pk2(bq.x * r * gb.x * pg8::fast_sigmoid(__uint_as_float(ou.z << 16)), bq.y * r * gb.y * pg8::fast_sigmoid(__uint_as_float(ou.z & 0xffff0000u)));
            o.w = pk2(bq.z * r * gb.z * pg8::fast_sigmoid(__uint_as_float(ou.w << 16)), bq.w * r * gb.w * pg8::fast_sigmoid(__uint_as_float(ou.w & 0xffff0000u)));
            yp[c] = o; }
    }
    __syncthreads();
}

__device__ __forceinline__ void ph_mixers(Frame& F, int l, unsigned char* lds_generic, const int dup) {
    using attn_body::AttnArgs; using attn_body::attn_unit;
#ifndef MIX_ONLY
#define MIX_ONLY -1
#endif
    if ((MIX_ONLY < 0 || MIX_ONLY == 0) && !(DBG_NAIVE_BITS & 1) && (dup == 0 || (dup & 1))) {
        const int c_lo = (l == 0) ? 0 : 2, ncz = NCHUNK - c_lo, nunits = 8 * ncz;
        for (int u = F.vcu; u < nunits; u += F.G) { const int bh = u / ncz, cidx = c_lo + u % ncz; ml_out_unit(F, l, bh >> 2, bh & 3, cidx, dup ? F.MERGED() : F.PROJ() + PJ_MLQ); }
    }
    const float L2E = 1.4426950408889634f;
    float score_bound;
    { float qm = fabsf(F.qn_g()[l * 64 + F.lane()]), km = fabsf(F.kn_g()[l * 64 + F.lane()]);
#pragma unroll
      for (int o = 1; o < 64; o <<= 1) { qm = fmaxf(qm, __shfl_xor(qm, o)); km = fmaxf(km, __shfl_xor(km, o)); }
      const unsigned sbu = __builtin_amdgcn_readfirstlane(__float_as_uint(64.0f * 0.125f * L2E * 1.01f * qm * km)); score_bound = __uint_as_float(sbu); }
    typedef attn_body::bf16 abf;
    abf* P = (abf*)F.PROJ();
    for (int pass = 0; pass < 2; ++pass)
        for (int u = F.vcu; u < 1024; u += F.G) {
            const int combo = (u >> 6) & 3, hq = u >> 8, qb = u & 63;
            const int b = combo >> 1, g = combo & 1, h = g * 4 + hq;
            AttnArgs A;
            A.pq = 512; A.pkv = 256; A.qrow0 = ROWS_CTX + b * SEQ + qb * 256; A.ctxrow0 = b * 256; A.latrow0 = ROWS_CTX + b * SEQ; A.q0 = qb * 256;
            if (MIX_ONLY >= 0 && MIX_ONLY != 1 + pass) continue;
            if (DBG_NAIVE_BITS & (pass == 0 ? 2 : 4)) continue;
            if (dup != 0 && !(dup & (pass == 0 ? 2 : 4))) continue;
            if (pass == 0) { A.Q = P + PJ_WQ + h * 64; A.K = P + PJ_WKV + g * 64; A.V = A.K + 128; A.O = (abf*)A.Q; A.sink_l2 = F.win_sink()[l * 8 + h] * L2E; if (dup) A.O = (abf*)F.MERGED() + h * 64;
                attn_unit<1, 8>(A, (char*)lds_generic); }
            else { A.Q = P + PJ_GQ + h * 64; A.K = P + PJ_GKV + g * 64; A.V = A.K + 128; A.O = (abf*)A.Q; A.sink_l2 = -INFINITY; if (dup) A.O = (abf*)F.MERGED() + h * 64;
                if (score_bound <= 40.0f) attn_unit<3, 8>(A, (char*)lds_generic); else attn_unit<0, 8>(A, (char*)lds_generic); }
        }
    if (l == 0 && (MIX_ONLY < 0 || MIX_ONLY == 3) && (dup == 0 || (dup & 8)))
        for (int u = F.vcu - (F.G - 32); u >= 0 && u < 32; u += F.G) {
            const int br = u >> 4, b = (u >> 3) & 1, h = u & 7, g = h >> 2;
            if (DBG_NAIVE_BITS & (br == 0 ? 2 : 4)) continue;
            AttnArgs A;
            A.pq = 512; A.pkv = 256; A.qrow0 = b * 256; A.ctxrow0 = b * 256; A.latrow0 = 0; A.q0 = 0;
            A.Q = P + (br ? PJ_GQ : PJ_WQ) + h * 64; A.K = P + (br ? PJ_GKV : PJ_WKV) + g * 64; A.V = A.K + 128; A.O = (abf*)A.Q;
            A.sink_l2 = br ? -INFINITY : F.win_sink()[l * 8 + h] * L2E; if (dup) A.O = (abf*)F.MERGED() + h * 64;
            attn_unit<2, 8>(A, (char*)lds_generic);
        }
}
__device__ __forceinline__ void ph_final(Frame& F, const bool dummy) {
    const int gw = F.vcu * NWAVES + F.wave, NGW = F.G * NWAVES;
    for (int row = gw; row < ROWS_LAT; row += NGW) {
        float* xr = F.out() + (size_t)row * 1024; f32x4 v[4]; float ss = 0.f;
#pragma unroll
        for (int j = 0; j < 4; ++j) { v[j] = *(const f32x4*)(xr + 4 * F.lane() + 256 * j); ss += (v[j].x * v[j].x + v[j].y * v[j].y) + (v[j].z * v[j].z + v[j].w * v[j].w); }
        const float rstd = 1.0f / sqrtf(wave_sum(ss) * (1.0f / 1024.0f) + NORM_EPS);
#pragma unroll
        for (int j = 0; j < 4; ++j) { const f32x4 g = *(const f32x4*)(F.final_g() + 4 * F.lane() + 256 * j); f32x4 o = v[j] * rstd * g;
            if (DBG_ZERO == 1 && row >= 16384) o = (f32x4){0.f, 0.f, 0.f, 0.f};
            if (DBG_ZERO == 2 && (row & 16383) >= 8192) o = (f32x4){0.f, 0.f, 0.f, 0.f};
            if (DBG_ZERO == 3 && j >= 2) o = (f32x4){0.f, 0.f, 0.f, 0.f};
            if (DBG_ZERO == 4 && row < 16384) o = (f32x4){0.f, 0.f, 0.f, 0.f};
            if (DBG_ZERO == 5 && (row & 16383) < 8192) o = (f32x4){0.f, 0.f, 0.f, 0.f};
            *(f32x4*)((dummy ? (float*)F.HX() + (size_t)(row & 8191) * 1024 : xr) + 4 * F.lane() + 256 * j) = o; }
    }
}

#ifdef ONLY_PHASE
#define IN(k) (((k) == ONLY_PHASE) || ((k) == ONLY_PHASE + 11 && ONLY_PHASE > 0 && ONLY_PHASE < 12))
#else
#define IN(k) (lo <= (k) && (k) < hi)
#endif
#define SEAM(k) do { if (IN((k) + 1)) { xcd_barrier(bar); if (DBG_BAR2) xcd_barrier(bar); } } while (0)
#define STAGGER(us) do { if ((us) > 0 && (F.vcu & 1)) { const unsigned long long t0_ = __builtin_amdgcn_s_memrealtime(); while (__builtin_amdgcn_s_memrealtime() - t0_ < (unsigned long long)((us) * 100)) __builtin_amdgcn_s_sleep(8); } __syncthreads(); } while (0)
#define REP(bit) _Pragma("unroll") for (int rep_ = 0; rep_ < ((DBG_DUP & (bit)) ? 2 : 1); ++rep_)
#define REPGAIN(bit) (((DBG_DUP & (bit)) && rep_ == 0) ? 0.0f : 1.0f)
template <int l> __device__ __forceinline__ void layer_phases(Frame& F, const int lo, const int hi, const XcdBarrier& bar, unsigned char* lds) {
        const int pb = 1 + 11 * l;
        const int r0 = 0;
        const int r0b = (l == 1) ? ROWS_CTX : 0;
        const float* modl = F.small() + SM_MODV + l * 3 * 6144;
        if (IN(pb + 0)) { REP(1) { ph_norm<0>(F, l, 0); } SEAM(pb + 0); }
        if (IN(pb + 1)) { STAGGER(DBG_STG_PROJ); REP(2) { pg8::Gemm g{F.HX(), F.W(l) + W_P, ROWS, NPROJ, 1024}; pg8::StaticOrder S; S.init(ROWS, NPROJ, F.G, (int)blockIdx.x);
            pg8::EpiProj E{F.PROJ(), F.biasP(l)};
            pg8::gemm_phase<pg8::EpiProj, pg8::StaticOrder, true, true>(F.lds, g, S, E);
            if (l == 0) {
                pg8::Gemm g2{F.HX(), F.W(l) + W_G, ROWS_CTX, NGATE, 1024}; pg8::TailOrder S2; { const int nwg = (ROWS / 256) * (NPROJ / 256), c0 = nwg % F.G, nt2 = (ROWS_CTX / 256) * (NGATE / 256); S2.init(ROWS_CTX, NGATE, (c0 + nt2 <= F.G) ? c0 : 0, (int)blockIdx.x); }
                pg8::EpiGate E2{F.GSCTX(), NGATE, F.biasG(l), 0};
                pg8::gemm_phase<pg8::EpiGate, pg8::TailOrder, true, true>(F.lds, g2, S2, E2); } } SEAM(pb + 1); }
        if (IN(pb + 2)) { ph_rope(F, l);
            REP(4) for (int u = F.vcu; u < 16 * NCHUNK; u += F.G) { const int chain = u / NCHUNK, cidx = u % NCHUNK; ml_local_unit(F, chain >> 3, (chain >> 2) & 1, chain & 3, cidx); }
            SEAM(pb + 2); }
        if (IN(pb + 3)) { if (DBG_DUP & 0x4000) ph_scan(F, true); ph_scan(F, false); SEAM(pb + 3); }
        if (IN(pb + 4)) { if (DBG_DUP & 0x1E00) ph_mixers(F, l, lds, (DBG_DUP >> 9) & 15); ph_mixers(F, l, lds, 0); SEAM(pb + 4); }
        bf16* Gs = F.PROJ() + PJ_MLK;
        if (IN(pb + 5)) { STAGGER(DBG_STG_GATES); REP(8) { pg8::Gemm g{F.HX() + (size_t)ROWS_CTX * 1024, F.W(l) + W_G, ROWS_LAT, NGATE, 1024}; pg8::StaticOrder S; S.init(ROWS_LAT, NGATE, F.G, (int)blockIdx.x);
            pg8::EpiGate E{Gs, NGATE, F.biasG(l), ROWS_CTX};
            pg8::gemm_phase<pg8::EpiGate, pg8::StaticOrder, true, true>(F.lds, g, S, E); } SEAM(pb + 5); }
        if (IN(pb + 6)) { STAGGER(DBG_STG_MERGE); REP(16) {
            _Pragma("unroll") for (int br = 0; br < 3; ++br) {
                pg8::Gemm g{F.PROJ() + PJ_MLQ + (size_t)br * A512 + (size_t)r0b * 512, F.W(l) + W_BR + (size_t)br * 1024 * 512, ROWS - r0b, 1024, 512, 0, 0};
                pg8::StaticOrder S; S.init(ROWS - r0b, 1024, F.G, (int)blockIdx.x);
                pg8::EpiMerge<true> E{Gs + br * 1024, F.GSCTX() + br * 1024, NGATE, F.MERGED(), r0b, 1.0f, br}; pg8::gemm_phase<pg8::EpiMerge<true>, pg8::StaticOrder, true, true>(F.lds, g, S, E); } }
            SEAM(pb + 6); }
        if (IN(pb + 7)) { STAGGER(DBG_STG_WO); REP(32) { pg8::Gemm g{F.MERGED() + (size_t)r0b * 1024, F.W(l) + W_O, ROWS - r0b, 1024, 1024}; pg8::StaticOrder S; S.init(ROWS - r0b, 1024, F.G, (int)blockIdx.x);
            pg8::EpiResid E{l == 0 ? F.ctx() : F.xc(), l == 0 ? F.x() : F.out(), F.xc(), F.out(), modl + 2048, r0b, REPGAIN(32)};
            pg8::gemm_phase<pg8::EpiResid, pg8::StaticOrder, true, true>(F.lds, g, S, E); } SEAM(pb + 7); }
        if (IN(pb + 8)) { REP(64) ph_norm<1>(F, l, r0b); SEAM(pb + 8); }
        bf16* Hb = F.PROJ();
        if (IN(pb + 9)) { STAGGER(DBG_STG_FFN1); REP(128) { pg8::Gemm g{F.HX() + (size_t)r0b * 1024, F.W(l) + W_13, ROWS - r0b, 5632, 1024}; pg8::StaticOrder S; S.init(ROWS - r0b, 5632, F.G, (int)blockIdx.x);
            pg8::EpiFFN1 E{Hb, r0b};
            pg8::gemm_phase<pg8::EpiFFN1, pg8::StaticOrder, true, true>(F.lds, g, S, E); } SEAM(pb + 9); }
        if (IN(pb + 10)) { STAGGER(DBG_STG_FFN2); REP(256) { pg8::Gemm g{Hb + (size_t)r0b * DFF, F.W(l) + W_2, ROWS - r0b, 1024, DFF}; pg8::StaticOrder S; S.init(ROWS - r0b, 1024, F.G, (int)blockIdx.x);
            pg8::EpiResid E{F.xc(), F.out(), F.xc(), F.out(), modl + 5120, r0b, REPGAIN(256)};
            pg8::gemm_phase<pg8::EpiResid, pg8::StaticOrder, true, true>(F.lds, g, S, E); } SEAM(pb + 10); }
        (void)r0;
}
__global__ void __launch_bounds__(NWAVES * 64, 2) fwd_kernel(Args args) {
    extern __shared__ __attribute__((aligned(16))) unsigned char lds[];
    Frame F{args};
    F.lds = (LAS unsigned char*)lds;
    F.MISC = (volatile LAS unsigned*)(F.lds + MISC_OFF);
    F.tid = threadIdx.x; F.wave = __builtin_amdgcn_readfirstlane(F.tid >> 6);
    F.G = gridDim.x; { const int bx = blockIdx.x; F.vcu = (F.G % 8 == 0) ? (bx % 8) * (F.G / 8) + bx / 8 : bx; }
    for (int u = F.tid; u < 32; u += NWAVES * 64) ((LAS unsigned*)(F.lds + MISC_OFF))[u] = 0u;
    __syncthreads();
    const int lo = args.ph_lo, hi = args.ph_hi;
    const bool use_bar = (hi - lo) > 1;
    XcdBarrier bar; bar.bar = (unsigned*)(F.ctl() + CW_BAR); bar.x = 0; bar.st = nullptr;
    if (use_bar) bar = xcd_barrier_post((unsigned*)(F.ctl() + CW_BAR), F.MISC + 8);

    if (IN(0)) { REP(0x2000) ph_prologue(F); SEAM(0); }
    layer_phases<0>(F, lo, hi, bar, lds);
    layer_phases<1>(F, lo, hi, bar, lds);
    if (IN(23)) { if (DBG_DUP & 0x8000) ph_final(F, true); ph_final(F, false); }
#undef IN
#undef SEAM
}


#if defined(DBG_NAIVE)
__global__ void __launch_bounds__(256) naive_attn(unsigned char* ws, const float* win_sink, int l, int mode) {
    bf16* PROJ = (bf16*)(ws + WS_PROJ);
    const int nrows = (mode < 2) ? ROWS_LAT : ROWS_CTX;
    const long idx = (long)blockIdx.x * 256 + threadIdx.x; if (idx >= (long)nrows * 8) return;
    const int h = (int)(idx / nrows), rr = (int)(idx % nrows), g = h >> 2;
    const int b = (mode < 2) ? (rr >> 14) : (rr >> 8); const int t = (mode < 2) ? (rr & 16383) : 0;
    const int row = (mode < 2) ? ROWS_CTX + rr : rr;
    const bool glob = (mode == 0 || mode == 3);
    bf16* qp = PROJ + (glob ? PJ_GQ : PJ_WQ) + (size_t)row * 512 + h * 64;
    const bf16* KV = PROJ + (glob ? PJ_GKV : PJ_WKV);
    float q[64], o[64];
#pragma unroll
    for (int d = 0; d < 64; ++d) { q[d] = bf2f(qp[d]); o[d] = 0.f; }
    float m = -INFINITY, lsum = 0.f;
    const int nctx = 256; int k_lo = 0, k_hi = -1;
    if (mode == 0) { k_lo = 0; k_hi = SEQ - 1; } else if (mode == 1) { k_lo = max(t - 128, 0); k_hi = min(t + 128, SEQ - 1); }
    const int ntot = nctx + (k_hi - k_lo + 1);
    for (int j = 0; j < ntot; ++j) {
        const int krow = j < nctx ? b * 256 + j : ROWS_CTX + b * SEQ + k_lo + (j - nctx);
        const bf16* kp = KV + (size_t)krow * 256 + g * 64; const bf16* vp = kp + 128;
        float s = 0.f;
#pragma unroll
        for (int d = 0; d < 64; ++d) s += q[d] * bf2f(kp[d]);
        const float mn = fmaxf(m, s), f = exp2f(m - mn), p = exp2f(s - mn);
        lsum = lsum * f + p;
#pragma unroll
        for (int d = 0; d < 64; ++d) o[d] = o[d] * f + p * bf2f(vp[d]);
        m = mn;
    }
    if (mode == 1 || mode == 2) lsum += exp2f(win_sink[l * 8 + h] * 1.4426950408889634f - m);
    const float inv = 1.0f / lsum;
#pragma unroll
    for (int d = 0; d < 64; ++d) qp[d] = (bf16)f2bf(o[d] * inv);
}
__global__ void __launch_bounds__(192) naive_mlstm(unsigned char* ws) {
    __shared__ float sq[128], sk[128], sden;
    bf16* PROJ = (bf16*)(ws + WS_PROJ); const float* gatesf = (const float*)(ws + WS_GATESF); bf16* HD = (bf16*)(ws + WS_MERGED);
    const int chain = blockIdx.x, b = chain >> 3, dir = (chain >> 2) & 1, h = chain & 3, dv = threadIdx.x;
    float C[128];
#pragma unroll
    for (int i = 0; i < 128; ++i) C[i] = 0.f;
    const float scale = 0.08838834764831845f;
    for (int step = 0; step < 256 + SEQ; ++step) {
        int row;
        if (step < 256) row = b * 256 + (dir ? 255 - step : step); else { const int tt = step - 256; row = ROWS_CTX + b * SEQ + (dir ? SEQ - 1 - tt : tt); }
        __syncthreads();
        if (dv < 128) { sq[dv] = bf2f(PROJ[PJ_MLQ + (size_t)row * 512 + h * 128 + dv]); sk[dv] = bf2f(PROJ[PJ_MLK + (size_t)row * 512 + h * 128 + dv]); }
        const float ig = gatesf[(size_t)row * 16 + dir * 4 + h], fg = gatesf[(size_t)row * 16 + 8 + dir * 4 + h];
        const float fw = expf(log_sigmoid_f(fg)), iw = expf(ig);
        const float v = dv < 128 ? bf2f(PROJ[PJ_MLV + (size_t)row * 512 + h * 128 + dv]) : 1.0f;
        __syncthreads();
        float num = 0.f;
        if (dv < 129) {
#pragma unroll
            for (int i = 0; i < 128; ++i) { C[i] = fw * C[i] + iw * sk[i] * v; num += sq[i] * C[i]; }
            num *= scale;
            if (dv == 128) sden = num;
        }
        __syncthreads();
        if (dv < 128) HD[((size_t)dir * ROWS + row) * 512 + h * 128 + dv] = (bf16)f2bf(num / fmaxf(fabsf(sden), 1.0f));
    }
}
__global__ void __launch_bounds__(256) naive_mlstm_finish(unsigned char* ws, const float* ml_norm_g, int l, int row_lo) {
    bf16* PROJ = (bf16*)(ws + WS_PROJ); const bf16* HD = (const bf16*)(ws + WS_MERGED);
    const int gw = blockIdx.x * 4 + (threadIdx.x >> 6), lane = threadIdx.x & 63; const int nitems = (ROWS - row_lo) * 4; if (gw >= nitems) return;
    const int row = row_lo + gw / 4, h = gw % 4;
    const float v0 = bf2f(HD[(size_t)row * 512 + h * 128 + 2 * lane]) + bf2f(HD[((size_t)ROWS + row) * 512 + h * 128 + 2 * lane]);
    const float v1 = bf2f(HD[(size_t)row * 512 + h * 128 + 2 * lane + 1]) + bf2f(HD[((size_t)ROWS + row) * 512 + h * 128 + 2 * lane + 1]);
    float ss = v0 * v0 + v1 * v1;
#pragma unroll
    for (int o = 1; o < 64; o <<= 1) ss += __shfl_xor(ss, o);
    const float r = 1.0f / sqrtf(ss * (1.0f / 128.0f) + NORM_EPS);
    const float* gn = ml_norm_g + (size_t)(l * 4 + h) * 128;
    const float o0 = bf2f(PROJ[PJ_MLO + (size_t)row * 512 + h * 128 + 2 * lane]), o1 = bf2f(PROJ[PJ_MLO + (size_t)row * 512 + h * 128 + 2 * lane + 1]);
    PROJ[PJ_MLQ + (size_t)row * 512 + h * 128 + 2 * lane] = (bf16)f2bf(v0 * r * gn[2 * lane] / (1.0f + expf(-o0)));
    PROJ[PJ_MLQ + (size_t)row * 512 + h * 128 + 2 * lane + 1] = (bf16)f2bf(v1 * r * gn[2 * lane + 1] / (1.0f + expf(-o1)));
}
#endif

#if defined(DBG_NGEMM)
template <int NACC, class WLoad, class Epi> __global__ void __launch_bounds__(256) naive_gemm(const bf16* A, int lda, int K, WLoad wl, Epi epi) {
    __shared__ float As[16][132]; __shared__ float Ws[NACC][16][68];
    const int tid = threadIdx.x, tx = tid & 15, ty = tid >> 4; const int m0 = blockIdx.y * 128, n0 = blockIdx.x * 64;
    float acc[NACC][8][4];
#pragma unroll
    for (int a = 0; a < NACC; ++a)
#pragma unroll
        for (int i = 0; i < 8; ++i)
#pragma unroll
            for (int j = 0; j < 4; ++j) acc[a][i][j] = 0.f;
    for (int k0 = 0; k0 < K; k0 += 16) {
#pragma unroll
        for (int i = 0; i < 8; ++i) { const int idx = tid + 256 * i, r = idx >> 4, kk = idx & 15; As[kk][r] = bf2f(A[(size_t)(m0 + r) * lda + k0 + kk]); }
#pragma unroll
        for (int a = 0; a < NACC; ++a)
#pragma unroll
            for (int i = 0; i < 4; ++i) { const int idx = tid + 256 * i, kk = idx >> 6, c = idx & 63; Ws[a][kk][c] = wl(a, k0 + kk, n0 + c); }
        __syncthreads();
#pragma unroll
        for (int kk = 0; kk < 16; ++kk) { float av[8];
#pragma unroll
            for (int i = 0; i < 8; ++i) av[i] = As[kk][ty * 8 + i];
#pragma unroll
            for (int a = 0; a < NACC; ++a) { float wv[4];
#pragma unroll
                for (int j = 0; j < 4; ++j) wv[j] = Ws[a][kk][tx * 4 + j];
#pragma unroll
                for (int i = 0; i < 8; ++i)
#pragma unroll
                    for (int j = 0; j < 4; ++j) acc[a][i][j] += av[i] * wv[j]; } }
        __syncthreads();
    }
#pragma unroll
    for (int i = 0; i < 8; ++i)
#pragma unroll
        for (int j = 0; j < 4; ++j) { float v[NACC];
#pragma unroll
            for (int a = 0; a < NACC; ++a) v[a] = acc[a][i][j];
            epi(m0 + ty * 8 + i, n0 + tx * 4 + j, v); }
}
struct NWPlain { const float* W; int ldw; int col0; __device__ float operator()(int, int k, int n) const { return W[(size_t)k * ldw + col0 + n]; } };
struct NWProj { const float* W; __device__ static int src(int n) { return n < 2048 ? n : n < 2560 ? 2064 + (n - 2048) : n < 3072 ? 2832 + (n - 2560) : n < 3328 ? 2576 + (n - 3072) : 3344 + (n - 3328); }
    __device__ float operator()(int, int k, int n) const { return W[(size_t)k * DIN + src(n)]; } };
struct NWBt { const bf16* Bt; int K; __device__ float operator()(int, int k, int n) const { return bf2f(Bt[(size_t)n * K + k]); } };
struct NWPair { const float* W1; const float* W3; __device__ float operator()(int a, int k, int n) const { return (a ? W3 : W1)[(size_t)k * DFF + n]; } };
struct NEProj { bf16* P; const float* b_in; __device__ void operator()(int m, int n, const float* v) const {
        const float x = v[0] + b_in[NWProj::src(n)]; size_t off; int ldc, c;
        if (n < 2048) { const int a = n >> 9; off = a == 0 ? PJ_MLQ : a == 1 ? PJ_MLK : a == 2 ? PJ_MLV : PJ_MLO; ldc = 512; c = n & 511; }
        else if (n < 2560) { off = PJ_WQ; ldc = 512; c = n - 2048; } else if (n < 3072) { off = PJ_GQ; ldc = 512; c = n - 2560; }
        else if (n < 3328) { off = PJ_WKV; ldc = 256; c = n - 3072; } else { off = PJ_GKV; ldc = 256; c = n - 3328; }
        P[off + (size_t)m * ldc + c] = (bf16)f2bf(x); } };
struct NEGate { bf16* G; const float* b_in; int r0, pad; __device__ void operator()(int m, int n, const float* v) const { const float x = v[0] + b_in[3600 + n]; G[(size_t)(r0 + m) * NGATE + n] = (bf16)f2bf(1.0f / (1.0f + expf(-x))); } };
struct NEMerge { const bf16* G; bf16* O; int r0, first; __device__ void operator()(int m, int n, const float* v) const { const size_t row = r0 + m; float x = v[0] * bf2f(G[row * NGATE + n]); if (!first) x += bf2f(O[row * 1024 + n]); O[row * 1024 + n] = (bf16)f2bf(x); } };
struct NEResid { const float* old_ctx; const float* old_lat; float* new_ctx; float* new_lat; const float* mod; int r0, pad; __device__ void operator()(int m, int n, const float* v) const {
        const int row = r0 + m; const bool isctx = row < ROWS_CTX; const int which = isctx ? 2 : ((row - ROWS_CTX) >> 14);
        const float xo = isctx ? old_ctx[(size_t)row * 1024 + n] : old_lat[(size_t)(row - ROWS_CTX) * 1024 + n];
        float* xn = isctx ? new_ctx + (size_t)row * 1024 + n : new_lat + (size_t)(row - ROWS_CTX) * 1024 + n;
        *xn = xo + mod[which * 6144 + n] * v[0]; } };
struct NEFfn1 { bf16* H; int r0, pad; __device__ void operator()(int m, int n, const float* v) const { H[(size_t)(r0 + m) * DFF + n] = (bf16)f2bf(v[0] / (1.0f + expf(-v[0])) * v[1]); } };
#endif

extern "C" void kernel_launch(void* const* d_in, const int* in_sizes, int n_in, void* d_out, int out_size, void* d_ws, size_t ws_size, hipStream_t stream) {
    static int grid = 0;
    if (grid == 0) {
        if (n_in != 20 || out_size != ROWS_LAT * 1024 || ws_size < WS_END) { fprintf(stderr, "kernel_launch: unexpected problem shape (n_in %d, out %d, ws %zu); nothing launched\n", n_in, out_size, ws_size); grid = -1; return; }
        int dev = 0, cus = 0, per_cu = 0;
        if (hipGetDevice(&dev) != hipSuccess || hipDeviceGetAttribute(&cus, hipDeviceAttributeMultiprocessorCount, dev) != hipSuccess) { grid = -1; return; }
        if (hipFuncSetAttribute((const void*)fwd_kernel, hipFuncAttributeMaxDynamicSharedMemorySize, LDS_BYTES) != hipSuccess) { fprintf(stderr, "kernel_launch: hipFuncSetAttribute failed\n"); grid = -1; return; }
        if (hipOccupancyMaxActiveBlocksPerMultiprocessor(&per_cu, (const void*)fwd_kernel, NWAVES * 64, LDS_BYTES) != hipSuccess || per_cu < 1) { fprintf(stderr, "kernel_launch: occupancy query reports %d workgroups per CU\n", per_cu); }
        (void)hipGetLastError();
        grid = cus;
    }
    if (grid < 0) return;
    if (hipMemsetAsync((char*)d_ws + WS_CTL, 0, CTL_ZERO_BYTES, stream) != hipSuccess) return;
    Args a{};
    for (int i = 0; i < 20; ++i) a.in[i] = (const float*)d_in[i];
    a.out = (float*)d_out; a.ws = (unsigned char*)d_ws;
#if MK_LAUNCH_PER_PHASE
    for (int p = 0; p < N_PHASES; ++p) {
#if defined(DBG_NAIVE)
        const int lp = (p >= 1 && p <= 22) ? (p - 1) % 11 : -1, ll = (p - 1) / 11;
        if (lp == 4) {
            a.ph_lo = p; a.ph_hi = p + 1;
            hipLaunchKernelGGL(fwd_kernel, dim3(grid), dim3(NWAVES * 64), LDS_BYTES, stream, a);
            unsigned char* wsb = (unsigned char*)d_ws;
            if (DBG_NAIVE & 1) { hipLaunchKernelGGL(naive_mlstm, dim3(16), dim3(192), 0, stream, wsb); hipLaunchKernelGGL(naive_mlstm_finish, dim3(ROWS), dim3(256), 0, stream, wsb, (const float*)d_in[9], ll, 0); }
            if (DBG_NAIVE & 2) { hipLaunchKernelGGL(naive_attn, dim3(ROWS_LAT * 8 / 256), dim3(256), 0, stream, wsb, (const float*)d_in[10], ll, 1); if (ll == 0) hipLaunchKernelGGL(naive_attn, dim3(ROWS_CTX * 8 / 256), dim3(256), 0, stream, wsb, (const float*)d_in[10], ll, 2); }
            if (DBG_NAIVE & 4) { hipLaunchKernelGGL(naive_attn, dim3(ROWS_LAT * 8 / 256), dim3(256), 0, stream, wsb, (const float*)d_in[10], ll, 0); if (ll == 0) hipLaunchKernelGGL(naive_attn, dim3(ROWS_CTX * 8 / 256), dim3(256), 0, stream, wsb, (const float*)d_in[10], ll, 3); }
            continue;
        }
#endif
#if defined(DBG_NGEMM)
        {
            const int lq = (p >= 1 && p <= 22) ? (p - 1) % 11 : -1, L = (p - 1) / 11; unsigned char* wsb = (unsigned char*)d_ws;
            bf16* HXp = (bf16*)(wsb + WS_HX); bf16* PJ = (bf16*)(wsb + WS_PROJ); bf16* MG = (bf16*)(wsb + WS_MERGED); float* SMALLp = (float*)(wsb + WS_SMALL); float* XC = (float*)(wsb + WS_XC);
            const float* w_in = (const float*)d_in[7] + (size_t)L * 1024 * DIN; const float* b_in = (const float*)d_in[8] + (size_t)L * DIN;
            const int r0b = (L == 1) ? ROWS_CTX : 0, Mr = ROWS - r0b; const float* modl = SMALLp + SM_MODV + L * 3 * 6144;
            if (lq == 1 && (DBG_NGEMM & 1)) { hipLaunchKernelGGL((naive_gemm<1, NWProj, NEProj>), dim3(NPROJ / 64, ROWS / 128), dim3(256), 0, stream, HXp, 1024, 1024, NWProj{w_in}, NEProj{PJ, b_in}); continue; }
            if (lq == 5 && (DBG_NGEMM & 128)) { a.ph_lo = p; a.ph_hi = p + 1; hipLaunchKernelGGL(fwd_kernel, dim3(grid), dim3(NWAVES * 64), LDS_BYTES, stream, a); }
            if (lq == 5 && (DBG_NGEMM & 64)) { hipLaunchKernelGGL((naive_gemm<1, NWBt, NEGate>), dim3(NGATE / 64, Mr / 128), dim3(256), 0, stream, HXp + (size_t)r0b * 1024, 1024, 1024, NWBt{(const bf16*)(wsb + (L ? WS_W2 : WS_W)) + W_G, 1024}, NEGate{PJ + PJ_MLK, b_in, r0b, 0}); continue; }
            if (lq == 5 && (DBG_NGEMM & 2)) { hipLaunchKernelGGL((naive_gemm<1, NWPlain, NEGate>), dim3(NGATE / 64, Mr / 128), dim3(256), 0, stream, HXp + (size_t)r0b * 1024, 1024, 1024, NWPlain{w_in, DIN, 3600}, NEGate{PJ + PJ_MLK, b_in, r0b, 0}); continue; }
            if (lq == 6 && (DBG_NGEMM & 4)) { for (int br = 0; br < 3; ++br) { const size_t yo = br == 0 ? PJ_MLQ : br == 1 ? PJ_WQ : PJ_GQ;
                    hipLaunchKernelGGL((naive_gemm<1, NWPlain, NEMerge>), dim3(1024 / 64, Mr / 128), dim3(256), 0, stream, PJ + yo + (size_t)r0b * 512, 512, 512, NWPlain{(const float*)d_in[13] + (size_t)(L * 3 + br) * 512 * 1024, 1024, 0}, NEMerge{PJ + PJ_MLK + br * 1024, MG, r0b, br == 0}); } continue; }
            if (lq == 7 && (DBG_NGEMM & 8)) { hipLaunchKernelGGL((naive_gemm<1, NWPlain, NEResid>), dim3(1024 / 64, Mr / 128), dim3(256), 0, stream, MG + (size_t)r0b * 1024, 1024, 1024, NWPlain{(const float*)d_in[14] + (size_t)L * 1024 * 1024, 1024, 0},
                    NEResid{L == 0 ? (const float*)d_in[2] : XC, L == 0 ? (const float*)d_in[0] : (float*)d_out, XC, (float*)d_out, modl + 2048, r0b, 0}); continue; }
            if (lq == 9 && (DBG_NGEMM & 16)) { hipLaunchKernelGGL((naive_gemm<2, NWPair, NEFfn1>), dim3(DFF / 64, Mr / 128), dim3(256), 0, stream, HXp + (size_t)r0b * 1024, 1024, 1024, NWPair{(const float*)d_in[16] + (size_t)L * 1024 * DFF, (const float*)d_in[17] + (size_t)L * 1024 * DFF}, NEFfn1{PJ, r0b, 0}); continue; }
            if (lq == 10 && (DBG_NGEMM & 32)) { hipLaunchKernelGGL((naive_gemm<1, NWPlain, NEResid>), dim3(1024 / 64, Mr / 128), dim3(256), 0, stream, PJ + (size_t)r0b * DFF, DFF, DFF, NWPlain{(const float*)d_in[18] + (size_t)L * DFF * 1024, 1024, 0},
                    NEResid{XC, (float*)d_out, XC, (float*)d_out, modl + 5120, r0b, 0}); continue; }
        }
#endif
        a.ph_lo = p; a.ph_hi = p + 1; hipLaunchKernelGGL(fwd_kernel, dim3(grid), dim3(NWAVES * 64), LDS_BYTES, stream, a); }
#else
    a.ph_lo = 0; a.ph_hi = N_PHASES;
    hipLaunchKernelGGL(fwd_kernel, dim3(grid), dim3(NWAVES * 64), LDS_BYTES, stream, a);
#endif
}
```

```cpp
#include <hip/hip_runtime.h>
#include <hip/hip_bf16.h>
#include <cstdio>
#include <cstdint>
#include <cmath>
#ifndef MK_LAUNCH_PER_PHASE
#define MK_LAUNCH_PER_PHASE 0
#endif
constexpr int ROWS_CTX = 512, ROWS_LAT = 32768, ROWS = ROWS_CTX + ROWS_LAT;
#ifndef DBG_GAIN_MIX
#define DBG_GAIN_MIX 1.0f
#endif
#ifndef DBG_GAIN_FFN
#define DBG_GAIN_FFN 1.0f
#endif
#ifndef DBG_GAIN_BR0
#define DBG_GAIN_BR0 1.0f
#endif
#ifndef DBG_GAIN_BR1
#define DBG_GAIN_BR1 1.0f
#endif
#ifndef DBG_GAIN_BR2
#define DBG_GAIN_BR2 1.0f
#endif
#ifndef DBG_ML_SKIPDIR
#define DBG_ML_SKIPDIR -1
#endif
#ifndef DBG_ZERO
#define DBG_ZERO 0
#endif
#if defined(DBG_NAIVE)
#define DBG_NAIVE_BITS (DBG_NAIVE)
#else
#define DBG_NAIVE_BITS 0
#endif
#ifndef DBG_DUP
#define DBG_DUP 0
#endif
#ifndef DBG_BAR2
#define DBG_BAR2 0
#endif
#ifndef DBG_STG_MERGE
#define DBG_STG_MERGE 0
#endif
#ifndef DBG_STG_WO
#define DBG_STG_WO 0
#endif
#ifndef DBG_STG_FFN2
#define DBG_STG_FFN2 0
#endif
#ifndef DBG_STG_PROJ
#define DBG_STG_PROJ 0
#endif
#ifndef DBG_STG_GATES
#define DBG_STG_GATES 0
#endif
#ifndef DBG_STG_FFN1
#define DBG_STG_FFN1 0
#endif

namespace pg8 {
#define PG8_LAS __attribute__((address_space(3)))
typedef unsigned short bf16_t;
typedef short bf16x8 __attribute__((ext_vector_type(8)));
typedef float f32x4 __attribute__((ext_vector_type(4)));
typedef unsigned u32x4 __attribute__((ext_vector_type(4)));
constexpr int BM = 256, BK = 64, HALF = 128, HTB = HALF * BK * 2  , STAGE_BYTES = 8 * HTB, NXCD = 8, WGM = 8;

__host__ __device__ __forceinline__ int lds_byte(int r, int c) { const int st = (r >> 4) * 2 + (c >> 5), rr = r & 15, cc = c & 31, ob = rr * 64 + cc * 2; return st * 1024 + (ob ^ (((ob >> 9) & 1) << 5)); }
__host__ __device__ __forceinline__ void stage_rc(int b, int& R, int& C) { const int st = b / 1024, sb = b % 1024, swz = sb ^ (((sb >> 9) & 1) << 5); R = (st >> 1) * 16 + swz / 64; C = (st & 1) * 32 + (swz % 64) / 2; }
__host__ __device__ __forceinline__ int perm32(int rho) { const int n = rho >> 4, i = rho & 15; return 8 * (i >> 2) + 4 * n + (i & 3); }

struct Unit { int pm, pn, z; };
struct Gemm { const bf16_t* A; const bf16_t* Bt; int M, N, K; size_t zA, zB; };

struct StaticOrder {
    int nM, nN, nwg, G, c;
    __host__ __device__ void init(int M, int N, int G_, int c_) { nM = M / BM; nN = N / BM; nwg = nM * nN; G = G_; c = c_; }
    __host__ __device__ bool next(int i, Unit& u) const {
        const long L = (long)i * G + c; if (L >= nwg) return false;
        int wgid = (int)L; { const int q = nwg / NXCD, r = nwg % NXCD, xcd = wgid % NXCD, off = wgid / NXCD; wgid = (xcd < r ? xcd * (q + 1) : r * (q + 1) + (xcd - r) * q) + off; }
        const int nig = WGM * nN, gid = wgid / nig, fm = gid * WGM, gsz = (nM - fm) < WGM ? (nM - fm) : WGM;
        u.pm = fm + ((wgid % nig) % gsz); u.pn = (wgid % nig) / gsz; u.z = 0; return true;
    }
    __device__ __forceinline__ void a_ready(const Unit&) const {}
    __device__ __forceinline__ void done(const Unit&) const {}
};

struct TailOrder {
    int nN, nt, c0, c;
    __host__ __device__ void init(int M, int N, int c0_, int c_) { nN = N / BM; nt = (M / BM) * nN; c0 = c0_; c = c_; }
    __host__ __device__ bool next(int i, Unit& u) const { const int j = c - c0; if (i != 0 || j < 0 || j >= nt) return false; u.pm = j / nN; u.pn = j % nN; u.z = 0; return true; }
    __device__ __forceinline__ void a_ready(const Unit&) const {}
    __device__ __forceinline__ void done(const Unit&) const {}
};
template <int NZ> struct ZOrder {
    StaticOrder S;
    __host__ __device__ void init(int M, int N, int G_, int c_) { S.init(M, N, G_, c_); }
    __host__ __device__ bool next(int i, Unit& u) const { if (!S.next(i / NZ, u)) return false; u.z = i % NZ; return true; }
    __device__ __forceinline__ void a_ready(const Unit&) const {}
    __device__ __forceinline__ void done(const Unit&) const {}
};

typedef float f32x2c_t __attribute__((ext_vector_type(2))); typedef __bf16 bf16x2c_t __attribute__((ext_vector_type(2)));
__device__ __forceinline__ unsigned cvt_pk_bf16(float lo, float hi) { f32x2c_t v = {lo, hi}; bf16x2c_t b = __builtin_convertvector(v, bf16x2c_t); return __builtin_bit_cast(unsigned, b); }
typedef float f32x2 __attribute__((ext_vector_type(2)));

__device__ __forceinline__ float bf_lo(unsigned u) { return __uint_as_float(u << 16); }
__device__ __forceinline__ float bf_hi(unsigned u) { return __uint_as_float(u & 0xffff0000u); }
__device__ __forceinline__ float fast_sigmoid(float x) { return __builtin_amdgcn_rcpf(1.0f + __builtin_amdgcn_exp2f(-1.4426950408889634f * x)); }

struct EpiProj {
    static constexpr bool PERM = true, AFTER_DRAIN = false;
    bf16_t* base; const float* bias;
    __device__ __forceinline__ void operator()(const f32x4 (&acc)[2][2][4][2], const Unit& u, int wr, int wc, int fr, int fq) const {
        const int pn = u.pn; const size_t A512 = (size_t)ROWS * 512;
        size_t aoff; int ldc, colt;
        if (pn < 8)       { const int a = pn >> 1; aoff = (a == 0 ? 0 : (size_t)(a + 2) * A512); ldc = 512; colt = (pn & 1) * 256; }
        else if (pn < 10) { aoff = A512; ldc = 512; colt = (pn & 1) * 256; }
        else if (pn < 12) { aoff = 2 * A512; ldc = 512; colt = (pn & 1) * 256; }
        else if (pn == 12) { aoff = 6 * A512; ldc = 256; colt = 0; }
        else               { aoff = 6 * A512 + (size_t)ROWS * 256; ldc = 256; colt = 0; }
        bf16_t* dst = base + aoff;
        const int row0 = u.pm * BM + wr * 64 + fr, col0 = colt + wc * 32 + 8 * fq, bcol0 = pn * BM + wc * 32 + 8 * fq;
        f32x4 bv[2][2];
#pragma unroll
        for (int bj = 0; bj < 2; ++bj)
#pragma unroll
            for (int n = 0; n < 2; ++n) bv[bj][n] = *(const f32x4*)(bias + bcol0 + bj * HALF + 4 * n);
#pragma unroll
        for (int ai = 0; ai < 2; ++ai)
#pragma unroll
            for (int m = 0; m < 4; ++m) { bf16_t* rowp = dst + (size_t)(row0 + ai * HALF + m * 16) * ldc + col0;
#pragma unroll
                for (int bj = 0; bj < 2; ++bj) { const f32x4 v0 = acc[ai][bj][m][0] + bv[bj][0], v1 = acc[ai][bj][m][1] + bv[bj][1];
                    u32x4 w; w.x = cvt_pk_bf16(v0[0], v0[1]); w.y = cvt_pk_bf16(v0[2], v0[3]); w.z = cvt_pk_bf16(v1[0], v1[1]); w.w = cvt_pk_bf16(v1[2], v1[3]);
                    *(u32x4*)(rowp + bj * HALF) = w; } }
    }
};
struct EpiGate {
    static constexpr bool PERM = true, AFTER_DRAIN = false;
    bf16_t* O; int ldc; const float* bias; int r0;
    __device__ __forceinline__ void operator()(const f32x4 (&acc)[2][2][4][2], const Unit& u, int wr, int wc, int fr, int fq) const {
        const int row0 = r0 + u.pm * BM + wr * 64 + fr, col0 = u.pn * BM + wc * 32 + 8 * fq;
        f32x4 bv[2][2];
#pragma unroll
        for (int bj = 0; bj < 2; ++bj)
#pragma unroll
            for (int n = 0; n < 2; ++n) bv[bj][n] = *(const f32x4*)(bias + col0 + bj * HALF + 4 * n);
#pragma unroll
        for (int ai = 0; ai < 2; ++ai)
#pragma unroll
            for (int m = 0; m < 4; ++m) { bf16_t* rowp = O + (size_t)(row0 + ai * HALF + m * 16) * ldc + col0;
#pragma unroll
                for (int bj = 0; bj < 2; ++bj) { f32x4 v0 = acc[ai][bj][m][0] + bv[bj][0], v1 = acc[ai][bj][m][1] + bv[bj][1];
#pragma unroll
                    for (int e = 0; e < 4; ++e) { v0[e] = fast_sigmoid(v0[e]); v1[e] = fast_sigmoid(v1[e]); }
                    u32x4 w; w.x = cvt_pk_bf16(v0[0], v0[1]); w.y = cvt_pk_bf16(v0[2], v0[3]); w.z = cvt_pk_bf16(v1[0], v1[1]); w.w = cvt_pk_bf16(v1[2], v1[3]);
                    *(u32x4*)(rowp + bj * HALF) = w; } }
    }
};
template <bool FIRST_UNUSED> struct EpiMerge {
    static constexpr bool PERM = true, AFTER_DRAIN = false;
    const bf16_t* G0; const bf16_t* Gctx; int ldg; bf16_t* O; int r0; float gain; int pass;
    __device__ __forceinline__ void operator()(const f32x4 (&acc)[2][2][4][2], const Unit& u, int wr, int wc, int fr, int fq) const {
        const int row0 = r0 + u.pm * BM + wr * 64 + fr, col0 = u.pn * BM + wc * 32 + 8 * fq;
        const bf16_t* G = (r0 + u.pm * BM < ROWS_CTX) ? Gctx : G0; const bool FIRST = (pass == 0);
#pragma unroll
        for (int ai = 0; ai < 2; ++ai)
#pragma unroll
            for (int m = 0; m < 4; ++m) { const size_t row = (size_t)(row0 + ai * HALF + m * 16);
#pragma unroll
                for (int bj = 0; bj < 2; ++bj) {
                    const u32x4 g = *(const u32x4*)(G + row * ldg + col0 + bj * HALF);
                    f32x4 v0 = acc[ai][bj][m][0] * gain, v1 = acc[ai][bj][m][1] * gain;
                    v0[0] *= bf_lo(g.x); v0[1] *= bf_hi(g.x); v0[2] *= bf_lo(g.y); v0[3] *= bf_hi(g.y);
                    v1[0] *= bf_lo(g.z); v1[1] *= bf_hi(g.z); v1[2] *= bf_lo(g.w); v1[3] *= bf_hi(g.w);
                    bf16_t* op = O + row * 1024 + col0 + bj * HALF;
                    if (!FIRST) { const u32x4 p = *(const u32x4*)op;
                        v0[0] += bf_lo(p.x); v0[1] += bf_hi(p.x); v0[2] += bf_lo(p.y); v0[3] += bf_hi(p.y);
                        v1[0] += bf_lo(p.z); v1[1] += bf_hi(p.z); v1[2] += bf_lo(p.w); v1[3] += bf_hi(p.w); }
                    u32x4 w; w.x = cvt_pk_bf16(v0[0], v0[1]); w.y = cvt_pk_bf16(v0[2], v0[3]); w.z = cvt_pk_bf16(v1[0], v1[1]); w.w = cvt_pk_bf16(v1[2], v1[3]);
                    *(u32x4*)op = w; } }
    }
};
struct EpiResid {
    static constexpr bool PERM = false, AFTER_DRAIN = false;
    const float* old_ctx; const float* old_lat; float* new_ctx; float* new_lat; const float* mod;   int r0; float gain;
    __device__ __forceinline__ void operator()(const f32x4 (&acc)[2][2][4][2], const Unit& u, int wr, int wc, int fr, int fq) const {
        const int trow = r0 + u.pm * BM;
        const bool isctx = trow < ROWS_CTX; const int which = isctx ? 2 : ((trow - ROWS_CTX) >> 14);
        const float* xo = isctx ? old_ctx + (size_t)trow * 1024 : old_lat + (size_t)(trow - ROWS_CTX) * 1024;
        float* xn = isctx ? new_ctx + (size_t)trow * 1024 : new_lat + (size_t)(trow - ROWS_CTX) * 1024;
        const float* mv = mod + which * 6144;
        const int col0 = u.pn * BM + wc * 32 + 4 * fq;
        f32x4 mm[2][2];
#pragma unroll
        for (int bj = 0; bj < 2; ++bj)
#pragma unroll
            for (int n = 0; n < 2; ++n) mm[bj][n] = *(const f32x4*)(mv + col0 + bj * HALF + n * 16);
#pragma unroll
        for (int ai = 0; ai < 2; ++ai)
#pragma unroll
            for (int m = 0; m < 4; ++m) { const size_t off = (size_t)(ai * HALF + wr * 64 + m * 16 + fr) * 1024 + col0;
#pragma unroll
                for (int bj = 0; bj < 2; ++bj)
#pragma unroll
                    for (int n = 0; n < 2; ++n) { const f32x4 b = *(const f32x4*)(xo + off + bj * HALF + n * 16);
                        *(f32x4*)(xn + off + bj * HALF + n * 16) = b + mm[bj][n] * acc[ai][bj][m][n] * gain; } }
    }
};
struct EpiFFN1 {
    static constexpr bool PERM = true, AFTER_DRAIN = false;
    bf16_t* O; int r0;
    __device__ __forceinline__ void operator()(const f32x4 (&acc)[2][2][4][2], const Unit& u, int wr, int wc, int fr, int fq) const {
        const int row0 = r0 + u.pm * BM + wr * 64 + fr, col0 = u.pn * HALF + wc * 32 + 8 * fq;
#pragma unroll
        for (int ai = 0; ai < 2; ++ai)
#pragma unroll
            for (int m = 0; m < 4; ++m) { bf16_t* rowp = O + (size_t)(row0 + ai * HALF + m * 16) * 2816 + col0;
                f32x4 v0, v1;
#pragma unroll
                for (int e = 0; e < 4; ++e) { const float g0 = acc[ai][0][m][0][e], g1 = acc[ai][0][m][1][e];
                    v0[e] = g0 * fast_sigmoid(g0) * acc[ai][1][m][0][e]; v1[e] = g1 * fast_sigmoid(g1) * acc[ai][1][m][1][e]; }
                u32x4 w; w.x = cvt_pk_bf16(v0[0], v0[1]); w.y = cvt_pk_bf16(v0[2], v0[3]); w.z = cvt_pk_bf16(v1[0], v1[1]); w.w = cvt_pk_bf16(v1[2], v1[3]);
                *(u32x4*)rowp = w; }
    }
};

template <class Epi, class Sched, bool ALIGN_EPI = false, bool SP2 = false>
__device__ __forceinline__ void gemm_phase(PG8_LAS unsigned char* lds, const Gemm g, const Sched& S, const Epi& E) {
    const int tid = threadIdx.x, wid = __builtin_amdgcn_readfirstlane(tid >> 6), lane = tid & 63, wr = wid >> 2, wc = wid & 3, fr = lane & 15, fq = lane >> 4;
    const int K = g.K, nt = K / BK;
    unsigned voffA[2], voffB[2];
#pragma unroll
    for (int i = 0; i < 2; ++i) { int R, C; stage_rc(tid * 16 + i * 8192, R, C); const int Rb = Epi::PERM ? ((R & ~31) + perm32(R & 31)) : R;
        voffA[i] = (unsigned)(R * K + C) * 2u; voffB[i] = (unsigned)(Rb * K + C) * 2u; }
    const size_t kstep = (size_t)(BK * 2);
    const size_t hstep = (size_t)HALF * K * 2;
    const size_t tstep = 2 * hstep;
    const unsigned ldsw = (unsigned)wid * 1024u;
    const int aoff = lds_byte(wr * 64 + fr, fq * 8), boff = lds_byte(wc * 32 + fr, fq * 8);
#define PG8_SA(b, h) (((b) * 2 + (h)) * HTB)
#define PG8_SB(b, h) ((4 + (b) * 2 + (h)) * HTB)
#define PG8_STAGE(bufoff, gbase, voff) do { _Pragma("unroll") for (int _i = 0; _i < 2; ++_i) \
        __builtin_amdgcn_global_load_lds((const unsigned*)((const char*)(gbase) + (voff)[_i]), (PG8_LAS unsigned*)(lds + (bufoff) + ldsw + _i * 8192), 16, 0, 0); } while (0)
#define PG8_LDA(dst, b, h) do { _Pragma("unroll") for (int m = 0; m < 4; ++m) _Pragma("unroll") for (int k = 0; k < 2; ++k) dst[m][k] = *(const PG8_LAS bf16x8*)(lds + PG8_SA(b, h) + aoff + m * 2048 + k * 1024); } while (0)
#define PG8_LDB(dst, b, h) do { _Pragma("unroll") for (int n = 0; n < 2; ++n) _Pragma("unroll") for (int k = 0; k < 2; ++k) dst[n][k] = *(const PG8_LAS bf16x8*)(lds + PG8_SB(b, h) + boff + n * 2048 + k * 1024); } while (0)
#define PG8_MMA(ai, bj, At, Bt) do { __builtin_amdgcn_s_setprio(1); _Pragma("unroll") for (int m = 0; m < 4; ++m) _Pragma("unroll") for (int n = 0; n < 2; ++n) _Pragma("unroll") for (int k = 0; k < 2; ++k) \
        acc[ai][bj][m][n] = __builtin_amdgcn_mfma_f32_16x16x32_bf16(Bt[n][k], At[m][k], acc[ai][bj][m][n], 0, 0, 0); __builtin_amdgcn_s_setprio(0); } while (0)
#define PG8_WAIT_V(n) asm volatile("s_waitcnt vmcnt(" #n ")" ::: "memory")
#define PG8_WAIT_L(n) asm volatile("s_waitcnt lgkmcnt(" #n ")" ::: "memory")
#define PG8_BAR __builtin_amdgcn_s_barrier()
#define PG8_SCHED __builtin_amdgcn_sched_barrier(0)
    Unit cur, nxt; int ui = 0;
    if (!S.next(0, cur)) return;
    f32x4 acc[2][2][4][2];
#pragma unroll
    for (int a = 0; a < 2; ++a)
#pragma unroll
        for (int b = 0; b < 2; ++b)
#pragma unroll
            for (int m = 0; m < 4; ++m)
#pragma unroll
                for (int n = 0; n < 2; ++n) acc[a][b][m][n] = (f32x4){0.f, 0.f, 0.f, 0.f};
    bf16x8 At[4][2], B0[2][2], B1[2][2];
    const char* cA = (const char*)g.A + ((size_t)cur.z * g.zA) * 2 + (size_t)cur.pm * tstep; const char* cB = (const char*)g.Bt + ((size_t)cur.z * g.zB) * 2 + (size_t)cur.pn * tstep;
    S.a_ready(cur);
    if constexpr (SP2) {
        PG8_STAGE(PG8_SB(0, 0), cB, voffB); PG8_STAGE(PG8_SB(0, 1), cB + hstep, voffB); PG8_STAGE(PG8_SA(0, 0), cA, voffA); PG8_STAGE(PG8_SA(0, 1), cA + hstep, voffA);
        if (wr == 1) PG8_BAR;
        PG8_WAIT_V(2); PG8_BAR;
        PG8_STAGE(PG8_SB(1, 0), cB + kstep, voffB); PG8_STAGE(PG8_SA(1, 0), cA + kstep, voffA); PG8_STAGE(PG8_SB(1, 1), cB + hstep + kstep, voffB);
        PG8_WAIT_V(6); PG8_BAR;
    } else {
        PG8_STAGE(PG8_SB(0, 0), cB, voffB); PG8_STAGE(PG8_SA(0, 0), cA, voffA); PG8_STAGE(PG8_SB(0, 1), cB + hstep, voffB); PG8_STAGE(PG8_SA(0, 1), cA + hstep, voffA);
        if (wr == 1) PG8_BAR;
        PG8_WAIT_V(4); PG8_BAR;
        PG8_STAGE(PG8_SB(1, 0), cB + kstep, voffB); PG8_STAGE(PG8_SA(1, 0), cA + kstep, voffA); PG8_STAGE(PG8_SB(1, 1), cB + hstep + kstep, voffB);
        PG8_WAIT_V(6); PG8_BAR;
    }
    for (;;) {
        const bool has_next = S.next(ui + 1, nxt);
        const char* nA = has_next ? (const char*)g.A + ((size_t)nxt.z * g.zA) * 2 + (size_t)nxt.pm * tstep : cA; const char* nB = has_next ? (const char*)g.Bt + ((size_t)nxt.z * g.zB) * 2 + (size_t)nxt.pn * tstep : cB;
        for (int t = 0; t < nt; t += 2) {
            const bool last = (t == nt - 2);
            const char* a1 = cA + (size_t)(t + 1) * kstep;
            const char* a2 = last ? nA : cA + (size_t)(t + 2) * kstep; const char* b2 = last ? nB : cB + (size_t)(t + 2) * kstep;
            const char* a3 = a2 + kstep; const char* b3 = b2 + kstep;
            if (last && has_next) S.a_ready(nxt);
            if constexpr (SP2) {
            PG8_LDB(B0, 0, 0); PG8_LDB(B1, 0, 1); PG8_SCHED; PG8_LDA(At, 0, 0); PG8_STAGE(PG8_SA(1, 1), a1 + hstep, voffA);
            PG8_WAIT_V(8); PG8_WAIT_L(0); PG8_BAR; PG8_MMA(0, 0, At, B0); PG8_MMA(0, 1, At, B1); PG8_BAR; PG8_SCHED;
            PG8_LDA(At, 0, 1); PG8_STAGE(PG8_SB(0, 0), b2, voffB); PG8_STAGE(PG8_SB(0, 1), b2 + hstep, voffB); PG8_STAGE(PG8_SA(0, 0), a2, voffA);
            PG8_WAIT_V(8); PG8_WAIT_L(0); PG8_BAR; PG8_MMA(1, 0, At, B0); PG8_MMA(1, 1, At, B1); PG8_BAR; PG8_SCHED;
            PG8_LDB(B0, 1, 0); PG8_LDB(B1, 1, 1); PG8_SCHED; PG8_LDA(At, 1, 0); PG8_STAGE(PG8_SA(0, 1), a2 + hstep, voffA);
            PG8_WAIT_V(8); PG8_WAIT_L(0); PG8_BAR; PG8_MMA(0, 0, At, B0); PG8_MMA(0, 1, At, B1); PG8_BAR; PG8_SCHED;
            PG8_LDA(At, 1, 1); PG8_STAGE(PG8_SB(1, 0), b3, voffB); PG8_STAGE(PG8_SB(1, 1), b3 + hstep, voffB); PG8_STAGE(PG8_SA(1, 0), a3, voffA);
            PG8_WAIT_V(8); PG8_WAIT_L(0); PG8_BAR; PG8_MMA(1, 0, At, B0); PG8_MMA(1, 1, At, B1); PG8_BAR; PG8_SCHED;
            } else {
            PG8_LDB(B0, 0, 0); PG8_SCHED; PG8_LDA(At, 0, 0); PG8_STAGE(PG8_SA(1, 1), a1 + hstep, voffA);
            PG8_WAIT_L(8); PG8_BAR; PG8_WAIT_L(0); PG8_MMA(0, 0, At, B0); PG8_BAR; PG8_SCHED;
            PG8_LDB(B1, 0, 1); PG8_STAGE(PG8_SB(0, 0), b2, voffB);
            PG8_BAR; PG8_WAIT_L(0); PG8_MMA(0, 1, At, B1); PG8_BAR;
            PG8_LDA(At, 0, 1); PG8_STAGE(PG8_SA(0, 0), a2, voffA);
            PG8_BAR; PG8_WAIT_L(0); PG8_MMA(1, 0, At, B0); PG8_BAR; PG8_SCHED;
            PG8_STAGE(PG8_SB(0, 1), b2 + hstep, voffB);
            PG8_WAIT_V(6); PG8_BAR; PG8_MMA(1, 1, At, B1); PG8_BAR;
            PG8_LDB(B0, 1, 0); PG8_SCHED; PG8_LDA(At, 1, 0); PG8_STAGE(PG8_SA(0, 1), a2 + hstep, voffA);
            PG8_WAIT_L(8); PG8_BAR; PG8_WAIT_L(0); PG8_MMA(0, 0, At, B0); PG8_BAR; PG8_SCHED;
            PG8_LDB(B1, 1, 1); PG8_STAGE(PG8_SB(1, 0), b3, voffB);
            PG8_BAR; PG8_WAIT_L(0); PG8_MMA(0, 1, At, B1); PG8_BAR;
            PG8_LDA(At, 1, 1); PG8_STAGE(PG8_SA(1, 0), a3, voffA);
            PG8_BAR; PG8_WAIT_L(0); PG8_MMA(1, 0, At, B0); PG8_BAR; PG8_SCHED;
            PG8_STAGE(PG8_SB(1, 1), b3 + hstep, voffB);
            PG8_WAIT_V(6); PG8_BAR; PG8_MMA(1, 1, At, B1); PG8_BAR;
            }
        }
        if constexpr (ALIGN_EPI) { if (wr == 0) PG8_BAR; }
        if constexpr (!Epi::AFTER_DRAIN) { E(acc, cur, wr, wc, fr, fq); S.done(cur); }
        if (!has_next) break;
#pragma unroll
        for (int a = 0; a < 2; ++a)
#pragma unroll
            for (int b = 0; b < 2; ++b)
#pragma unroll
                for (int m = 0; m < 4; ++m)
#pragma unroll
                    for (int n = 0; n < 2; ++n) acc[a][b][m][n] = (f32x4){0.f, 0.f, 0.f, 0.f};
        cur = nxt; cA = nA; cB = nB; ++ui;
        if constexpr (ALIGN_EPI) { if (wr == 1) PG8_BAR; }
    }
    PG8_WAIT_V(0);
    if constexpr (!ALIGN_EPI) { if (wr == 0) PG8_BAR; }
    PG8_BAR;
    if constexpr (Epi::AFTER_DRAIN) { E.fused(acc, cur, wr, wc, fr, fq, lds, wid, lane); S.done(cur); }
#undef PG8_SA
#undef PG8_SB
#undef PG8_STAGE
#undef PG8_LDA
#undef PG8_LDB
#undef PG8_MMA
#undef PG8_WAIT_V
#undef PG8_WAIT_L
#undef PG8_BAR
#undef PG8_SCHED
}

}

namespace attn_body {
using bf16=__hip_bfloat16;
using bf16x8=__attribute__((ext_vector_type(8)))short;
using s16x4=__attribute__((ext_vector_type(4)))short;
using f32x16=__attribute__((ext_vector_type(16)))float;
using u32x4=__attribute__((ext_vector_type(4)))unsigned;
constexpr int SEQ=16384,D=64;
constexpr int NW=8,QBLK=32,QB=QBLK*NW,KVBLK=64;
constexpr int ATTN_UNIT_ROWS=QB;
__device__ __forceinline__ int crow(int r,int hi){return (r&3)+8*(r>>2)+4*hi;}
#define SBAR() __builtin_amdgcn_sched_barrier(0)
__device__ __forceinline__ float min3z(float a,float b){float r;asm("v_min3_f32 %0, %1, %2, 0":"=v"(r):"v"(a),"v"(b));return r;}
__device__ __forceinline__ void wmask(f32x16&p0,f32x16&p1,int klo,int khi,int hi){
  const float A=(float)(4*hi-klo), B=(float)(khi-4*hi);
  #pragma unroll
  for(int r=0;r<16;++r){const float c=(float)((r&3)+8*(r>>2));
    p0[r]=__builtin_fmaf(min3z(A+c,B-c),1e30f,p0[r]); p1[r]=__builtin_fmaf(min3z(A+(c+32.f),B-(c+32.f)),1e30f,p1[r]);}
}

constexpr int NSLOT=3, SLOTB=8192;
constexpr int LDS_K=0, LDS_V=NSLOT*SLOTB, LDS_WS=2*NSLOT*SLOTB, LDS_OST=LDS_WS+NW*64*4, LDS_BYTES=LDS_OST+NW*4096;
constexpr float C2=0.125f*1.4426950408889634f;
__device__ __forceinline__ void glds16(const void*gsrc,unsigned lds_dst){unsigned keep;
  asm volatile("s_mov_b32 %0, m0\n\ts_mov_b32 m0, %2\n\ts_nop 0\n\tglobal_load_lds_dwordx4 %1, off\n\ts_mov_b32 m0, %0":"=&s"(keep):"v"(gsrc),"s"(lds_dst):"memory");}
__device__ __forceinline__ float max3f(float a,float b,float c){float r;asm("v_max3_f32 %0, %1, %2, %3":"=v"(r):"v"(a),"v"(b),"v"(c));return r;}
__device__ __forceinline__ float max2f(float a,float b){float r;asm("v_max_f32_e32 %0, %1, %2":"=v"(r):"v"(a),"v"(b));return r;}
__device__ __forceinline__ float fadd_s(float a,float b){float r;asm("v_add_f32_e32 %0, %1, %2":"=v"(r):"v"(a),"v"(b));return r;}
__device__ __forceinline__ float fsub_s(float a,float b){float r;asm("v_sub_f32_e32 %0, %1, %2":"=v"(r):"v"(a),"v"(b));return r;}
typedef float f32x2_t __attribute__((ext_vector_type(2))); typedef __bf16 bf16x2_t __attribute__((ext_vector_type(2)));
__device__ __forceinline__ unsigned cvtpk_s(float lo,float hi){f32x2_t v={lo,hi};bf16x2_t b=__builtin_convertvector(v,bf16x2_t);return __builtin_bit_cast(unsigned,b);}
#define WAIT_BAR(N) asm volatile("s_waitcnt vmcnt(" #N ") lgkmcnt(0)\n\ts_barrier":::"memory")

__device__ __forceinline__ void qkt(f32x16&p0,f32x16&p1,const char*Kslot,const bf16x8*qr,const f32x16&negm,int r32,int hi){
  const char*kb=Kslot+hi*1024+r32*16;
  #pragma unroll
  for(int d0=0;d0<4;++d0){
    const bf16x8 b0=*reinterpret_cast<const bf16x8*>(kb+d0*2048);
    const bf16x8 b1=*reinterpret_cast<const bf16x8*>(kb+d0*2048+512);
    if(d0==0){p0=__builtin_amdgcn_mfma_f32_32x32x16_bf16(b0,qr[0],negm,0,0,0);p1=__builtin_amdgcn_mfma_f32_32x32x16_bf16(b1,qr[0],negm,0,0,0);}
    else{p0=__builtin_amdgcn_mfma_f32_32x32x16_bf16(b0,qr[d0],p0,0,0,0);p1=__builtin_amdgcn_mfma_f32_32x32x16_bf16(b1,qr[d0],p1,0,0,0);}}
}
typedef __attribute__((address_space(3))) const char* lds_cptr;
typedef short v4i16_t __attribute__((ext_vector_type(4)));
__device__ __forceinline__ void kload8(bf16x8*kf,lds_cptr kp){
  kf[0]=*(const __attribute__((address_space(3))) bf16x8*)(kp);      kf[1]=*(const __attribute__((address_space(3))) bf16x8*)(kp+512);
  kf[2]=*(const __attribute__((address_space(3))) bf16x8*)(kp+2048); kf[3]=*(const __attribute__((address_space(3))) bf16x8*)(kp+2560);
  kf[4]=*(const __attribute__((address_space(3))) bf16x8*)(kp+4096); kf[5]=*(const __attribute__((address_space(3))) bf16x8*)(kp+4608);
  kf[6]=*(const __attribute__((address_space(3))) bf16x8*)(kp+6144); kf[7]=*(const __attribute__((address_space(3))) bf16x8*)(kp+6656);
}
__device__ __forceinline__ void kload2(bf16x8*kf,lds_cptr kp,int j){ kf[2*j]=*(const __attribute__((address_space(3))) bf16x8*)(kp+j*2048); kf[2*j+1]=*(const __attribute__((address_space(3))) bf16x8*)(kp+j*2048+512); }
__device__ __forceinline__ s16x4 vtr(lds_cptr p){ return __builtin_bit_cast(s16x4,__builtin_amdgcn_ds_read_tr16_b64_v4i16((__attribute__((address_space(3))) v4i16_t*)p)); }
__device__ __forceinline__ float rowmax(const f32x16&p0,const f32x16&p1){
  float a=max3f(p0[0],p0[1],p1[0]),b=max3f(p0[2],p0[3],p1[1]);a=max3f(a,p1[2],p1[3]);
  #pragma unroll
  for(int r=4;r<16;r+=4){a=max3f(a,p0[r],p0[r+1]);b=max3f(b,p0[r+2],p0[r+3]);a=max3f(a,p1[r],p1[r+1]);b=max3f(b,p1[r+2],p1[r+3]);}
  const float m=max2f(a,b);
  auto rr=__builtin_amdgcn_permlane32_swap(__float_as_uint(m),__float_as_uint(m),false,false);
  return max2f(__uint_as_float(rr[0]),__uint_as_float(rr[1]));
}
__device__ __forceinline__ void pv(f32x16*o,int vb,bf16x8 pa0,bf16x8 pa1,bf16x8 pa2,bf16x8 pa3){
  #pragma unroll
  for(int d0=0;d0<2;++d0){s16x4 lo[4],hi[4];
    #pragma unroll
    for(int ks=0;ks<4;++ks){
      asm volatile("ds_read_b64_tr_b16 %0,%1 offset:%c2":"=&v"(lo[ks]):"v"(vb),"i"(d0*4096+ks*1024):"memory");
      asm volatile("ds_read_b64_tr_b16 %0,%1 offset:%c2":"=&v"(hi[ks]):"v"(vb),"i"(d0*4096+ks*1024+512):"memory");}
    asm volatile("s_waitcnt lgkmcnt(0)":::"memory");SBAR();
    #define PK(k) (bf16x8){lo[k][0],lo[k][1],lo[k][2],lo[k][3],hi[k][0],hi[k][1],hi[k][2],hi[k][3]}
    o[d0]=__builtin_amdgcn_mfma_f32_32x32x16_bf16(pa0,PK(0),o[d0],0,0,0);
    o[d0]=__builtin_amdgcn_mfma_f32_32x32x16_bf16(pa1,PK(1),o[d0],0,0,0);
    o[d0]=__builtin_amdgcn_mfma_f32_32x32x16_bf16(pa2,PK(2),o[d0],0,0,0);
    o[d0]=__builtin_amdgcn_mfma_f32_32x32x16_bf16(pa3,PK(3),o[d0],0,0,0);
    #undef PK
  }
}

#ifndef ATTN_STORE16
#define ATTN_STORE16(p,v) (*(u32x4*)(p)=(v))
#endif

struct AttnArgs { const bf16* Q; const bf16* K; const bf16* V; bf16* O; int pq, pkv; int qrow0; int ctxrow0, latrow0; int q0; float sink_l2; };
template<int MODE,int THRL> __device__ __forceinline__ void attn_unit(const AttnArgs&A,char*shm){
  constexpr int NT=(MODE==0||MODE==3)?260:(MODE==1)?12:4; constexpr bool PLAINC=(MODE==1||MODE==3);
  const bf16*Q=A.Q;const bf16*__restrict__ K=A.K;const bf16*__restrict__ V=A.V;bf16*O=A.O; const int PQ=A.pq,PKV=A.pkv;
  const int tid=threadIdx.x,lane=tid&63,r32=lane&31,hi=lane>>5; const int wid=__builtin_amdgcn_readfirstlane(tid>>6);
  const bf16*Qw=Q+(long)(A.qrow0+wid*QBLK)*PQ;
  const bf16*Kh=K,*Vh=V;
  const unsigned lds0=(unsigned)(uintptr_t)shm;
  float*wsf=(float*)(shm+LDS_WS)+wid*64;
  const bf16*ksrc=Kh+(long)lane*PKV+wid*8;
  const bf16*vsrc=Vh+(long)(16*(wid&3)+(lane>>2))*PKV+(wid>>2)*32+(lane&3)*8;
  const unsigned kdst=lds0+LDS_K+wid*1024, vdst=lds0+LDS_V+wid*1024;
  #define KROW(t) ( ((t)<4) ? (A.ctxrow0+64*(t)) : (MODE==1 ? (A.latrow0+min(max(A.q0-128+64*((t)-4),0),SEQ-64)) : (A.latrow0+64*((t)-4))) )
  #define DMA_K(t,slot) glds16(ksrc+(long)KROW(t)*PKV,(unsigned)__builtin_amdgcn_readfirstlane(kdst+(slot)))
  #define DMA_V(t,slot) glds16(vsrc+(long)KROW(t)*PKV,(unsigned)__builtin_amdgcn_readfirstlane(vdst+(slot)))
  const int vb0=(int)(lds0+LDS_V)+((lane>>4)&1)*32+(lane&3)*8+(4*hi+((lane&15)>>2))*64;
  const char*Kbase=shm+LDS_K; bf16x8 kf[8];
  const lds_cptr shm3=(lds_cptr)shm; const lds_cptr kp0=shm3+LDS_K+hi*1024+r32*16; const lds_cptr vp0=shm3+LDS_V+((lane>>4)&1)*32+(lane&3)*8+(4*hi+((lane&15)>>2))*64;
  DMA_K(0,0);DMA_V(0,0);DMA_K(1,SLOTB);
  bf16x8 qr[4];
  #pragma unroll
  for(int d0=0;d0<4;++d0)qr[d0]=*reinterpret_cast<const bf16x8*>(&Qw[(long)r32*PQ+d0*16+hi*8]);
  float mhat=0.f,l_reg=0.f;f32x16 o[2];o[0]=f32x16{};o[1]=f32x16{};f32x16 negm=f32x16{}; if(!PLAINC){asm volatile("":"+v"(negm));}
  const int qpos=A.q0+wid*QBLK+r32; const int kq_lo=max(qpos-128,0), kq_hi=min(qpos+128,SEQ-1);
  #define CMASK(P0,P1,t) do{ if(MODE==1){ if((t)>=4){ const int kb_=A.q0-128+64*((t)-4); int lo_=kq_lo-kb_,hi_=kq_hi-kb_; asm volatile("":"+v"(lo_),"+v"(hi_)); wmask(P0,P1,lo_,hi_,hi);} } }while(0)
  bool resc=false;
  #define START(P0,P1) do{ resc=false; \
    if(MODE!=3){ const float rm=rowmax(P0,P1); const float dl=rm; mhat=fadd_s(mhat,dl); \
      _Pragma("unroll") for(int r=0;r<16;++r){P0[r]=fsub_s(P0[r],dl);P1[r]=fsub_s(P1[r],dl);} \
      if(!PLAINC){ _Pragma("unroll") for(int r=0;r<16;++r)negm[r]=-mhat; asm volatile("":"+v"(negm)); } } \
    _Pragma("unroll") for(int r=0;r<16;++r)P0[r]=__builtin_amdgcn_exp2f(P0[r]); }while(0)
  #define RESC() do{ if(resc){ asm volatile("s_waitcnt lgkmcnt(0)":::"memory"); \
      _Pragma("unroll") for(int d_=0;d_<2;++d_) _Pragma("unroll") for(int r=0;r<16;++r)o[d_][r]*=wsf[crow(r,hi)]; } }while(0)
  f32x16 pA0,pA1,pB0,pB1;
  int sl_prev=0,sl_cur=0,sl_next=SLOTB;
  #define ROT() do{sl_prev=sl_cur;sl_cur=sl_next;sl_next=(sl_next==(NSLOT-1)*SLOTB)?0:sl_next+SLOTB;}while(0)
  DMA_K(2,2*SLOTB);
  WAIT_BAR(3);
  qkt(pA0,pA1,Kbase,qr,negm,r32,hi);asm volatile("s_nop 15\n\ts_nop 7":"+v"(pA0),"+v"(pA1));CMASK(pA0,pA1,0);
  START(pA0,pA1);
  _Pragma("unroll") for(int r=0;r<16;++r)pA1[r]=__builtin_amdgcn_exp2f(pA1[r]);
  WAIT_BAR(0);
  DMA_K(3,0);DMA_V(1,SLOTB);
  ROT();
  kload8(kf,kp0+sl_cur);
  WAIT_BAR(2);
  s16x4 vlo[8],vhi[8]; u32x4 pw0,pw1,pw2,pw3;
  #define PKW(P,B) cvtpk_s(P[B],P[B+1])
  #define PAF(k) __builtin_bit_cast(bf16x8,pw##k)
  #define VFR(i) (bf16x8){vlo[i][0],vlo[i][1],vlo[i][2],vlo[i][3],vhi[i][0],vhi[i][1],vhi[i][2],vhi[i][3]}
  #define PIN(x) asm volatile("":"+v"(x))
  #define MX3(a,b,c) __builtin_fmaxf(__builtin_fmaxf((a),(b)),(c))
  #define GAPA(MF,A0,A1,A2,A3,W0,W1,PW) do{ MF; sacc+=A0; sacc+=A1; sacc+=A2; sacc+=A3; PIN(sacc); W0; W1; PIN(PW); SBAR(); }while(0)
  #define EX(v) __builtin_amdgcn_exp2f(v)
  #define GAPB(MF,X,B) do{ MF; X[B]=EX(X[B]); X[B+1]=EX(X[B+1]); X[B+2]=EX(X[B+2]); X[B+3]=EX(X[B+3]); PIN(X); SBAR(); }while(0)
  #define VRD(i) do{ vlo[i]=vtr(vp_+(((i)>>2)*4096+((i)&3)*1024)); vhi[i]=vtr(vp_+(((i)>>2)*4096+((i)&3)*1024+512)); }while(0)
  #define KRD(G,j) do{ if(G){ kload2(kf,kp0+sl_next,j); SBAR(); } }while(0)
  #define STEP(C0,C1,P0,P1,t,GK,GV,GL) do{ SBAR(); \
    const lds_cptr vp_=vp0+sl_prev; \
    VRD(0); SBAR(); float sacc=(P0[0]+P0[1]); \
    GAPA(C0=__builtin_amdgcn_mfma_f32_32x32x16_bf16(kf[0],qr[0],negm,0,0,0), P0[2],P0[3],P0[4],P0[5],     pw0[0]=PKW(P0,0), pw0[1]=PKW(P0,2), pw0); \
    VRD(4); SBAR(); GAPA(C1=__builtin_amdgcn_mfma_f32_32x32x16_bf16(kf[1],qr[0],negm,0,0,0), P0[6],P0[7],P0[8],P0[9],     pw0[2]=PKW(P0,4), pw0[3]=PKW(P0,6), pw0); \
    VRD(1); SBAR(); GAPA(C0=__builtin_amdgcn_mfma_f32_32x32x16_bf16(kf[2],qr[1],C0,0,0,0),   P0[10],P0[11],P0[12],P0[13], pw1[0]=PKW(P0,8), pw1[1]=PKW(P0,10), pw1); \
    VRD(5); SBAR(); GAPA(C1=__builtin_amdgcn_mfma_f32_32x32x16_bf16(kf[3],qr[1],C1,0,0,0),   P0[14],P0[15],P1[0],P1[1],   pw1[2]=PKW(P0,12),pw1[3]=PKW(P0,14), pw1); \
    VRD(2); SBAR(); GAPA(C0=__builtin_amdgcn_mfma_f32_32x32x16_bf16(kf[4],qr[2],C0,0,0,0),   P1[2],P1[3],P1[4],P1[5],     pw2[0]=PKW(P1,0), pw2[1]=PKW(P1,2), pw2); \
    VRD(6); SBAR(); GAPA(C1=__builtin_amdgcn_mfma_f32_32x32x16_bf16(kf[5],qr[2],C1,0,0,0),   P1[6],P1[7],P1[8],P1[9],     pw2[2]=PKW(P1,4), pw2[3]=PKW(P1,6), pw2); \
    VRD(3); SBAR(); GAPA(C0=__builtin_amdgcn_mfma_f32_32x32x16_bf16(kf[6],qr[3],C0,0,0,0),   P1[10],P1[11],P1[12],P1[13], pw3[0]=PKW(P1,8), pw3[1]=PKW(P1,10), pw3); \
    VRD(7); SBAR(); GAPA(C1=__builtin_amdgcn_mfma_f32_32x32x16_bf16(kf[7],qr[3],C1,0,0,0),   P1[14],P1[15],0.f,0.f,       pw3[2]=PKW(P1,12),pw3[3]=PKW(P1,14), pw3); \
    l_reg+=sacc; \
    if(GK){DMA_K((t)+3,sl_cur);} if(GV){DMA_V((t)+1,sl_next);} \
    if(MODE==1){ _Pragma("unroll") for(int r=0;r<16;++r){C0[r]-=mhat;C1[r]-=mhat;} } \
    CMASK(C0,C1,t); \
    if(MODE!=3){ float a=MX3(C0[0],C0[1],C1[0]),b=MX3(C0[2],C0[3],C1[1]); a=MX3(a,C1[2],C1[3]); \
      _Pragma("unroll") for(int r=4;r<16;r+=4){a=MX3(a,C0[r],C0[r+1]);b=MX3(b,C0[r+2],C0[r+3]);a=MX3(a,C1[r],C1[r+1]);b=MX3(b,C1[r+2],C1[r+3]);} \
      float rm=__builtin_fmaxf(a,b); { auto rr=__builtin_amdgcn_permlane32_swap(__float_as_uint(rm),__float_as_uint(rm),false,false); rm=__builtin_fmaxf(__uint_as_float(rr[0]),__uint_as_float(rr[1])); } \
      resc=false; \
      if(__builtin_expect(__any(rm>(float)THRL),0)){ const float dl=__builtin_fmaxf(rm,0.f); mhat+=dl; \
        _Pragma("unroll") for(int r=0;r<16;++r){C0[r]-=dl;C1[r]-=dl;} \
        if(!PLAINC){ _Pragma("unroll") for(int r=0;r<16;++r)negm[r]=-mhat; asm volatile("":"+v"(negm)); } \
        const float f=__builtin_amdgcn_exp2f(-dl); l_reg*=f; if(hi==0)wsf[r32]=f; resc=true; } } \
    SBAR(); \
    GAPB(o[0]=__builtin_amdgcn_mfma_f32_32x32x16_bf16(PAF(0),VFR(0),o[0],0,0,0), C0,0); \
    GAPB(o[1]=__builtin_amdgcn_mfma_f32_32x32x16_bf16(PAF(0),VFR(4),o[1],0,0,0), C0,4); \
    KRD(GL,0); GAPB(o[0]=__builtin_amdgcn_mfma_f32_32x32x16_bf16(PAF(1),VFR(1),o[0],0,0,0), C0,8); \
    KRD(GL,1); GAPB(o[1]=__builtin_amdgcn_mfma_f32_32x32x16_bf16(PAF(1),VFR(5),o[1],0,0,0), C0,12); \
    KRD(GL,2); GAPB(o[0]=__builtin_amdgcn_mfma_f32_32x32x16_bf16(PAF(2),VFR(2),o[0],0,0,0), C1,0); \
    KRD(GL,3); GAPB(o[1]=__builtin_amdgcn_mfma_f32_32x32x16_bf16(PAF(2),VFR(6),o[1],0,0,0), C1,4); \
    GAPB(o[0]=__builtin_amdgcn_mfma_f32_32x32x16_bf16(PAF(3),VFR(3),o[0],0,0,0), C1,8); \
    GAPB(o[1]=__builtin_amdgcn_mfma_f32_32x32x16_bf16(PAF(3),VFR(7),o[1],0,0,0), C1,12); \
    }while(0)
  int t=1;
  for(;t+5<NT;t+=2){
    STEP(pB0,pB1,pA0,pA1,t,true,true,true);     WAIT_BAR(2); RESC(); ROT();
    STEP(pA0,pA1,pB0,pB1,t+1,true,true,true);   WAIT_BAR(2); RESC(); ROT();
  }
  #define ENDW(tt) do{ if((tt)+3<NT){WAIT_BAR(2);} else if((tt)+2<NT){WAIT_BAR(1);} else {WAIT_BAR(0);} }while(0)
  for(;t+1<NT;t+=2){
    STEP(pB0,pB1,pA0,pA1,t,(t+3<NT),(t+1<NT),(t+1<NT));       ENDW(t);   RESC(); ROT();
    STEP(pA0,pA1,pB0,pB1,t+1,(t+4<NT),(t+2<NT),(t+2<NT));     ENDW(t+1); RESC(); ROT();
  }
  STEP(pB0,pB1,pA0,pA1,NT-1,false,false,false); RESC();
  { float sacc=pB0[0]+pB0[1]; _Pragma("unroll") for(int r=2;r<16;++r)sacc+=pB0[r]; _Pragma("unroll") for(int r=0;r<16;++r)sacc+=pB1[r]; l_reg+=sacc;
    pw0=(u32x4){PKW(pB0,0),PKW(pB0,2),PKW(pB0,4),PKW(pB0,6)};pw1=(u32x4){PKW(pB0,8),PKW(pB0,10),PKW(pB0,12),PKW(pB0,14)};pw2=(u32x4){PKW(pB1,0),PKW(pB1,2),PKW(pB1,4),PKW(pB1,6)};pw3=(u32x4){PKW(pB1,8),PKW(pB1,10),PKW(pB1,12),PKW(pB1,14)};
    SBAR(); pv(o,vb0+sl_cur,PAF(0),PAF(1),PAF(2),PAF(3)); }
  #undef PKW
  #undef PAF
  #undef VFR
  #undef PIN
  #undef MX3
  #undef GAPA
  #undef GAPB
  #undef EX
  #undef VRD
  #undef KRD
  #undef STEP
  #undef ENDW
  {auto rr=__builtin_amdgcn_permlane32_swap(__float_as_uint(l_reg),__float_as_uint(l_reg),false,false);l_reg=__uint_as_float(rr[0])+__uint_as_float(rr[1]);}
  l_reg+=__builtin_amdgcn_exp2f(A.sink_l2-mhat);
  if(hi==0)wsf[32+r32]=l_reg;asm volatile("s_waitcnt lgkmcnt(0)":::"memory");
  float rli[16];
  #pragma unroll
  for(int r=0;r<16;++r)rli[r]=__builtin_amdgcn_rcpf(wsf[32+crow(r,hi)]);
  bf16*Ow=O+(long)(A.qrow0+wid*QBLK)*PQ;
  { bf16*stg=(bf16*)(shm+LDS_OST)+wid*2048;
    #pragma unroll
    for(int r=0;r<16;++r){const int orow=crow(r,hi);
      #pragma unroll
      for(int d0=0;d0<2;++d0)stg[orow*64+d0*32+r32]=__float2bfloat16(o[d0][r]*rli[r]);}
    asm volatile("s_waitcnt lgkmcnt(0)":::"memory");
    #pragma unroll
    for(int i=0;i<4;++i){const int row=i*8+(lane>>3),ch=lane&7; const u32x4 v=*(const u32x4*)(stg+row*64+ch*8); ATTN_STORE16(Ow+(long)row*PQ+ch*8,v);} }
  asm volatile("s_waitcnt lgkmcnt(0)\n\ts_barrier":::"memory");
  #undef DMA_K
  #undef KROW
  #undef DMA_V
  #undef CMASK
  #undef START
  #undef RESC
  #undef ROT
}
constexpr int ATTN_LDS_BYTES=LDS_BYTES;

#undef SBAR
#undef WAIT_BAR
}

constexpr int NWAVES = 8;
constexpr int DM = 1024, SEQ = 16384, DIN = 6672, DFF = 2816, NPROJ = 3584, NGATE = 3072;
constexpr int NCHUNK = 130;
constexpr float NORM_EPS = 1e-6f;
constexpr int N_PHASES = 24;
constexpr size_t MiB = 1u << 20;
constexpr size_t WS_CTL = 0, CTL_ZERO_BYTES = 1 * MiB;
constexpr size_t WS_SMALL = 1 * MiB;
constexpr int SM_MODV = 0, SM_ROPE = 36864, SM_BIASP = 47104, SM_BIASG = 50688, SM_SC = 53760, SM_MB = 57920, SM_BIAS1 = 60000;
constexpr size_t WS_XC = 2 * MiB, WS_GATESF = 4 * MiB, WS_W = 8 * MiB, WS_HX = 44 * MiB, WS_PROJ = 110 * MiB, WS_ST = 338 * MiB, WS_MERGED = 406 * MiB, WS_W2 = 472 * MiB, WS_GSCTX = 507 * MiB, WS_END = 510 * MiB;
constexpr size_t A512 = (size_t)ROWS * 512;
constexpr size_t PJ_MLQ = 0, PJ_WQ = A512, PJ_GQ = 2 * A512, PJ_MLK = 3 * A512, PJ_MLV = 4 * A512, PJ_MLO = 5 * A512, PJ_WKV = 6 * A512, PJ_GKV = 6 * A512 + (size_t)ROWS * 256;
constexpr size_t W_P = 0, W_G = (size_t)NPROJ * 1024, W_BR = W_G + (size_t)NGATE * 1024, W_O = W_BR + (size_t)3 * 1024 * 512, W_13 = W_O + (size_t)1024 * 1024, W_2 = W_13 + (size_t)5632 * 1024;
constexpr int ST_ROWS = 132, ST_SLOT = ST_ROWS * 128;
static_assert(WS_W + (W_2 + (size_t)1024 * DFF) * 2 <= WS_HX && WS_HX + (size_t)ROWS * 1024 * 2 <= WS_PROJ && WS_PROJ + (PJ_GKV + (size_t)ROWS * 256) * 2 <= WS_ST, "ws map 1");
static_assert(WS_ST + (size_t)16 * NCHUNK * ST_SLOT * 2 <= WS_MERGED && WS_MERGED + (size_t)ROWS * 1024 * 2 <= WS_END, "ws map 2");
static_assert(WS_PROJ + PJ_MLK * 2 + (size_t)ROWS * NGATE * 2 <= WS_MERGED && (size_t)ROWS * DFF * 2 <= (WS_ST - WS_PROJ), "overlays");
constexpr int CW_BAR = 4096;
constexpr int RING_BYTES = 131072, MISC_OFF = 147456 - 128, LDS_BYTES = 147456;

#define GAS __attribute__((address_space(1)))
#define LAS __attribute__((address_space(3)))
typedef unsigned short bf16;
typedef unsigned v4u __attribute__((ext_vector_type(4)));
typedef unsigned v2u __attribute__((ext_vector_type(2)));
typedef float f32x4 __attribute__((ext_vector_type(4)));
typedef float f32x16 __attribute__((ext_vector_type(16)));
typedef short bf16x8 __attribute__((ext_vector_type(8)));
typedef short s16x4 __attribute__((ext_vector_type(4)));
typedef GAS unsigned gu32;
#define LDS_WAIT() asm volatile("s_waitcnt lgkmcnt(0)" ::: "memory")
#define VM_WAIT() asm volatile("s_waitcnt vmcnt(0)" ::: "memory")
__device__ __forceinline__ unsigned f2bf(float f) { unsigned u = __builtin_bit_cast(unsigned, f); return (u + 0x7fffu + ((u >> 16) & 1u)) >> 16; }
__device__ __forceinline__ unsigned pk2(float lo, float hi) { return f2bf(lo) | (f2bf(hi) << 16); }
__device__ __forceinline__ float bf2f(unsigned short h) { return __uint_as_float((unsigned)h << 16); }

#define XB_TMO      128
#define XB_XCNT(j)  (256  + 64 * (j))
#define XB_XSUB(j)  (1280 + 64 * (j))
#define XB_XGEN(j)  (2304 + 64 * (j))
#define XB_TOP      3328
#define XB_TOPGEN   3392
#define XCD_BAR_WORDS 3456
#define XB_SPIN_CAP (1u << 18)

__device__ __forceinline__ unsigned xb_ld(unsigned* p)              { return __hip_atomic_load(p, __ATOMIC_RELAXED, __HIP_MEMORY_SCOPE_AGENT); }
__device__ __forceinline__ unsigned xb_add(unsigned* p, unsigned v) { return __hip_atomic_fetch_add(p, v, __ATOMIC_RELAXED, __HIP_MEMORY_SCOPE_AGENT); }
__device__ __forceinline__ unsigned xb_xcc_id() { return (unsigned)__builtin_amdgcn_s_getreg((3 << 11) | 20) & 0xFu; }
#define XB_SPIN(cond, bar) do { unsigned _sp = 0; while (cond) { __builtin_amdgcn_s_sleep(1); \
    if ((++_sp & 255u) == 0u) { if (xb_ld(&(bar)[XB_TMO])) break; if (_sp > XB_SPIN_CAP) { atomicAdd(&(bar)[XB_TMO], 1u); break; } } } } while (0)

struct XcdBarrier {
    unsigned* bar; unsigned x;
    volatile LAS unsigned* st;
};

__device__ __forceinline__ XcdBarrier xcd_barrier_post(unsigned* bar, volatile LAS unsigned* st) {
    XcdBarrier b; b.bar = bar; b.x = xb_xcc_id(); b.st = st;
    if (threadIdx.x == 0) (void)xb_add(&bar[XB_XCNT(b.x)], 1u);
    return b;
}
__device__ __forceinline__ void xcd_barrier_complete(unsigned* bar, unsigned x, unsigned& nloc, unsigned& nx) {
    const unsigned G = gridDim.x * gridDim.y * gridDim.z;
    unsigned sum, cnt, mine, sp = 0u;
    for (;;) {
        sum = 0u; cnt = 0u; mine = 0u;
#pragma unroll
        for (unsigned j = 0; j < 16; ++j) { const unsigned c = xb_ld(&bar[XB_XCNT(j)]); sum += c; cnt += (c > 0u) ? 1u : 0u; mine = (j == x) ? c : mine; }
        if (sum == G) break;
        __builtin_amdgcn_s_sleep(1);
        if ((++sp & 255u) == 0u) { if (xb_ld(&bar[XB_TMO])) break; if (sp > XB_SPIN_CAP) { atomicAdd(&bar[XB_TMO], 1u); break; } }
    }
    nloc = mine > 0u ? mine : 1u; nx = cnt > 0u ? cnt : 1u;
}

__device__ __forceinline__ void xcd_barrier(const XcdBarrier& b) {
    asm volatile("s_waitcnt vmcnt(0)" ::: "memory");
    __syncthreads();
    if (threadIdx.x == 0) {
        unsigned* bar = b.bar;
        __builtin_amdgcn_s_waitcnt(0);
        unsigned nloc = b.st[0], nx = b.st[1];
        if (nloc == 0u) { xcd_barrier_complete(bar, b.x, nloc, nx); b.st[0] = nloc; b.st[1] = nx; }
        const unsigned old = xb_add(&bar[XB_XSUB(b.x)], 1u);
        const unsigned gen = old / nloc;
        if (old + 1u == (gen + 1u) * nloc) {
            __builtin_amdgcn_fence(__ATOMIC_RELEASE, "agent");
            asm volatile("s_waitcnt vmcnt(0)" ::: "memory");
            const unsigned og = xb_add(&bar[XB_TOP], 1u);
            const unsigned tg = og / nx;
            if (og + 1u == (tg + 1u) * nx) xb_add(&bar[XB_TOPGEN], 1u);
            else XB_SPIN(xb_ld(&bar[XB_TOPGEN]) == tg, bar);
            __builtin_amdgcn_fence(__ATOMIC_ACQUIRE, "agent");
            xb_add(&bar[XB_XGEN(b.x)], 1u);
            asm volatile("s_waitcnt vmcnt(0)" ::: "memory");
        } else {
            XB_SPIN(xb_ld(&bar[XB_XGEN(b.x)]) == gen, bar);
            __builtin_amdgcn_fence(__ATOMIC_ACQUIRE, "agent");
            asm volatile("s_waitcnt vmcnt(0)" ::: "memory");
        }
    }
    __syncthreads();
}


struct Args { const float* in[20]; float* out; unsigned char* ws; int ph_lo, ph_hi; };
struct Frame {
    const Args& A;
    LAS unsigned char* lds;
    volatile LAS unsigned* MISC;
    int tid, wave, vcu, G;
    __device__ __forceinline__ int lane() const { return tid & 63; }
#define FIN(name, idx) __device__ __forceinline__ const float* name() const { return A.in[idx]; }
    FIN(x, 0) FIN(c, 1) FIN(ctx, 2) FIN(c_ctx, 3) FIN(w_mod, 4) FIN(b_mod, 5) FIN(norm1_g, 6) FIN(w_in, 7) FIN(b_in, 8) FIN(ml_norm_g, 9) FIN(win_sink, 10) FIN(qn_g, 11) FIN(kn_g, 12)
    FIN(w_br, 13) FIN(w_o, 14) FIN(norm2_g, 15) FIN(w_ff1, 16) FIN(w_ff3, 17) FIN(w_ff2, 18) FIN(final_g, 19)
#undef FIN
    __device__ __forceinline__ float* out() const { return A.out; }
    __device__ __forceinline__ gu32* ctl() const { return (gu32*)(A.ws + WS_CTL); }
    __device__ __forceinline__ float* small() const { return (float*)(A.ws + WS_SMALL); }
    __device__ __forceinline__ float* xc() const { return (float*)(A.ws + WS_XC); }
    __device__ __forceinline__ float* gatesf() const { return (float*)(A.ws + WS_GATESF); }
    __device__ __forceinline__ bf16* W(int l) const { return (bf16*)(A.ws + (l ? WS_W2 : WS_W)); }
    __device__ __forceinline__ const float* biasP(int l) const { return small() + (l ? SM_BIAS1 : SM_BIASP); }
    __device__ __forceinline__ const float* biasG(int l) const { return small() + (l ? SM_BIAS1 + NPROJ : SM_BIASG); }
    __device__ __forceinline__ bf16* HX() const { return (bf16*)(A.ws + WS_HX); }
    __device__ __forceinline__ bf16* PROJ() const { return (bf16*)(A.ws + WS_PROJ); }
    __device__ __forceinline__ bf16* ST() const { return (bf16*)(A.ws + WS_ST); }
    __device__ __forceinline__ bf16* MERGED() const { return (bf16*)(A.ws + WS_MERGED); }
    __device__ __forceinline__ bf16* GSCTX() const { return (bf16*)(A.ws + WS_GSCTX); }
};
__device__ __forceinline__ float wave_sum(float v) {
#pragma unroll
    for (int o = 1; o < 64; o <<= 1) v += __shfl_xor(v, o);
    return v;
}
__device__ __forceinline__ void transpose_item(const float* W, int ldw, int srccol0, int K, bf16* WT, int dstrow0, int kb, LAS float* scr, int lane) {
    const int k0 = 64 * kb;
#pragma unroll 8
    for (int i = 0; i < 32; ++i) { const int kk = 2 * i + (lane >> 5); scr[kk * 33 + (lane & 31)] = W[(size_t)(k0 + kk) * ldw + srccol0 + (lane & 31)]; }
    LDS_WAIT(); asm volatile("" ::: "memory");
    const int c = lane & 7;
#pragma unroll
    for (int j = 0; j < 4; ++j) { const int n = (lane >> 3) + 8 * j; const LAS float* s = scr + (8 * c) * 33 + n;
        v4u o; o.x = pk2(s[0 * 33], s[1 * 33]); o.y = pk2(s[2 * 33], s[3 * 33]); o.z = pk2(s[4 * 33], s[5 * 33]); o.w = pk2(s[6 * 33], s[7 * 33]);
        *(GAS v4u*)(WT + (size_t)(dstrow0 + n) * K + k0 + 8 * c) = o; }
    LDS_WAIT(); asm volatile("" ::: "memory");
}
__device__ __forceinline__ void conv_weights(Frame& F, int l) {
    LAS float* scr = (LAS float*)(F.lds + F.wave * 16384);
    const int gw = F.vcu * NWAVES + F.wave, NGW = F.G * NWAVES;
    const float* w_in = F.w_in() + (size_t)l * 1024 * DIN;
    constexpr int I_P = 16 * 112, I_G = 16 * 96, I_BR = 3 * 8 * 32, I_O = 16 * 32, I_1 = 16 * 88, I_2 = 44 * 32;
    constexpr int NITEMS = I_P + I_G + I_BR + I_O + 2 * I_1 + I_2;
    for (int it = gw; it < NITEMS; it += NGW) {
        int r = it;
        if (r < I_P) { const int kb = r / 112, n0 = (r % 112) * 32;
            const int sc = n0 < 2048 ? n0 : n0 < 2560 ? 2064 + (n0 - 2048) : n0 < 3072 ? 2832 + (n0 - 2560) : n0 < 3328 ? 2576 + (n0 - 3072) : 3344 + (n0 - 3328);
            transpose_item(w_in, DIN, sc, 1024, F.W(l) + W_P, n0, kb, scr, F.lane()); continue; } r -= I_P;
        if (r < I_G) { const int kb = r / 96, n0 = (r % 96) * 32; transpose_item(w_in, DIN, 3600 + n0, 1024, F.W(l) + W_G, n0, kb, scr, F.lane()); continue; } r -= I_G;
        if (r < I_BR) { const int br = r / 256, rr = r % 256, kb = rr / 32, n0 = (rr % 32) * 32;
            transpose_item(F.w_br() + (size_t)(l * 3 + br) * 512 * 1024, 1024, n0, 512, F.W(l) + W_BR + (size_t)br * 1024 * 512, n0, kb, scr, F.lane()); continue; } r -= I_BR;
        if (r < I_O) { const int kb = r / 32, n0 = (r % 32) * 32; transpose_item(F.w_o() + (size_t)l * 1024 * 1024, 1024, n0, 1024, F.W(l) + W_O, n0, kb, scr, F.lane()); continue; } r -= I_O;
        if (r < I_1) { const int kb = r / 88, n0 = (r % 88) * 32; transpose_item(F.w_ff1() + (size_t)l * 1024 * DFF, DFF, n0, 1024, F.W(l) + W_13, (n0 / 128) * 256 + (n0 % 128), kb, scr, F.lane()); continue; } r -= I_1;
        if (r < I_1) { const int kb = r / 88, n0 = (r % 88) * 32; transpose_item(F.w_ff3() + (size_t)l * 1024 * DFF, DFF, n0, 1024, F.W(l) + W_13, (n0 / 128) * 256 + 128 + (n0 % 128), kb, scr, F.lane()); continue; } r -= I_1;
        { const int kb = r / 32, n0 = (r % 32) * 32; transpose_item(F.w_ff2() + (size_t)l * DFF * 1024, 1024, n0, DFF, F.W(l) + W_2, n0, kb, scr, F.lane()); }
    }
    const float* b_in = F.b_in() + (size_t)l * DIN;
    for (int i = F.vcu * 512 + F.tid; i < NPROJ + NGATE; i += F.G * 512) {
        if (i < NPROJ) { const int n0 = i; const int sc = n0 < 2048 ? n0 : n0 < 2560 ? 2064 + (n0 - 2048) : n0 < 3072 ? 2832 + (n0 - 2560) : n0 < 3328 ? 2576 + (n0 - 3072) : 3344 + (n0 - 3328);
            F.small()[(l ? SM_BIAS1 : SM_BIASP) + i] = b_in[sc]; }
        else F.small()[(l ? SM_BIAS1 + NPROJ : SM_BIASG) + (i - NPROJ)] = b_in[3600 + (i - NPROJ)];
    }
}
__device__ __forceinline__ void ph_prologue(Frame& F) {
    if (F.vcu < 192) {
        const int l = F.vcu / 96, jb = F.vcu % 96;
        LAS float* sl = (LAS float*)F.lds;
        LAS float* red = sl + 3072;
        for (int i = F.tid; i < 3072; i += 512) { const int w = i >> 10, k = i & 1023; const float v = w < 2 ? F.c()[w * 1024 + k] : F.c_ctx()[k]; sl[i] = v / (1.0f + expf(-v)); }
        __syncthreads();
        const float* W = F.w_mod() + (size_t)l * 1024 * 6144 + jb * 64 + F.lane();
        float a0 = 0.f, a1 = 0.f, a2 = 0.f;
        const int kbeg = 128 * F.wave;
#pragma unroll 16
        for (int k = kbeg; k < kbeg + 128; ++k) { const float w = W[(size_t)k * 6144]; a0 += w * sl[k]; a1 += w * sl[1024 + k]; a2 += w * sl[2048 + k]; }
        red[(F.wave * 3 + 0) * 64 + F.lane()] = a0; red[(F.wave * 3 + 1) * 64 + F.lane()] = a1; red[(F.wave * 3 + 2) * 64 + F.lane()] = a2;
        __syncthreads();
        if (F.tid < 192) { const int w = F.tid >> 6, col = F.tid & 63; float sacc = 0.f;
#pragma unroll
            for (int q = 0; q < 8; ++q) sacc += red[(q * 3 + w) * 64 + col];
            F.small()[SM_MODV + (l * 3 + w) * 6144 + jb * 64 + col] = sacc + F.b_mod()[l * 6144 + jb * 64 + col]; }
        __syncthreads();
    } else if (F.vcu == 192) {
        for (int i = F.tid; i < 5120; i += 512) { const bool isrow = i < 4096; const int j = isrow ? i : i - 4096; const int pos = j >> 4, fi = j & 15;
            const float inv = (float)pow(10000.0, -(double)(2 * fi) / 32.0); const float ang = (float)pos * inv;
            const float cs = (float)cos((double)ang), sn = (float)sin((double)ang);
            if (isrow) { F.small()[SM_ROPE + j] = cs; F.small()[SM_ROPE + 4096 + j] = sn; } else { F.small()[SM_ROPE + 8192 + j] = cs; F.small()[SM_ROPE + 8192 + 1024 + j] = sn; } }
    }
    conv_weights(F, 0);
    conv_weights(F, 1);
}
template <int WHICH> __device__ __forceinline__ void ph_norm(Frame& F, int l, int row_lo) {
    LAS float* wg = (LAS float*)F.lds;
    if (WHICH == 0) {
        __syncthreads();
        const float* w_in = F.w_in() + (size_t)l * 1024 * DIN + 2048;
        for (int i = F.tid; i < 16384; i += 512) { const int k = i >> 4, cc = i & 15; wg[cc * 1028 + k] = w_in[(size_t)k * DIN + cc]; }
        __syncthreads();
    }
    const float* gain = (WHICH == 0 ? F.norm1_g() : F.norm2_g()) + l * 1024;
    const float* modl = F.small() + SM_MODV + l * 3 * 6144;
    const int gw = F.vcu * NWAVES + F.wave, NGW = F.G * NWAVES;
    const int lane = F.lane();
    const bool srcin = (WHICH == 0 && l == 0);
    const float* src_ctx = srcin ? F.ctx() : F.xc(); const float* src_lat = srcin ? F.x() : F.out();
#define NORM_ROWPTR(r_) ((r_) < ROWS_CTX ? src_ctx + (size_t)(r_) * 1024 : src_lat + (size_t)((r_) - ROWS_CTX) * 1024)
    f32x4 gn[4];
#pragma unroll
    for (int j = 0; j < 4; ++j) gn[j] = *(const f32x4*)(gain + 4 * lane + 256 * j);
    if (WHICH == 1) {
        for (int rowq = row_lo + gw; rowq < ROWS; rowq += 4 * NGW) {
            f32x4 w4[4][4];
#pragma unroll
            for (int q = 0; q < 4; ++q) { const int r = rowq + q * NGW; if (r < ROWS) { const float* xr = NORM_ROWPTR(r);
#pragma unroll
                    for (int j = 0; j < 4; ++j) w4[q][j] = *(const f32x4*)(xr + 4 * lane + 256 * j); } }
#pragma unroll
            for (int q = 0; q < 4; ++q) { const int r = rowq + q * NGW; if (r < ROWS) {
                    const int which = r < ROWS_CTX ? 2 : ((r - ROWS_CTX) >> 14); const float* sh = modl + which * 6144 + 3072; const float* sc = sh + 1024;
                    float ss = 0.f;
#pragma unroll
                    for (int j = 0; j < 4; ++j) ss += (w4[q][j].x * w4[q][j].x + w4[q][j].y * w4[q][j].y) + (w4[q][j].z * w4[q][j].z + w4[q][j].w * w4[q][j].w);
                    const float rstd = 1.0f / sqrtf(wave_sum(ss) * (1.0f / 1024.0f) + NORM_EPS);
                    bf16* orow = F.HX() + (size_t)r * 1024;
#pragma unroll
                    for (int j = 0; j < 4; ++j) { const int c0 = 4 * lane + 256 * j; const f32x4 s1 = *(const f32x4*)(sc + c0), s0 = *(const f32x4*)(sh + c0);
                        const f32x4 y = (w4[q][j] * rstd * gn[j]) * (s1 + 1.0f) + s0; v2u o; o.x = pk2(y.x, y.y); o.y = pk2(y.z, y.w); *(GAS v2u*)(orow + c0) = o; } } }
        }
        return;
    }
    int row = row_lo + gw;
    f32x4 v[4], vn[4];
    if (row < ROWS) { const float* xr = NORM_ROWPTR(row);
#pragma unroll
        for (int j = 0; j < 4; ++j) v[j] = *(const f32x4*)(xr + 4 * lane + 256 * j); }
    for (; row < ROWS; row += NGW) {
        const int nrow = row + NGW;
        if (nrow < ROWS) { const float* xn = NORM_ROWPTR(nrow);
#pragma unroll
            for (int j = 0; j < 4; ++j) vn[j] = *(const f32x4*)(xn + 4 * lane + 256 * j); }
        const bool isctx = row < ROWS_CTX; const int which = isctx ? 2 : ((row - ROWS_CTX) >> 14);
        const float* sh = modl + which * 6144 + (WHICH == 0 ? 0 : 3072); const float* sc = sh + 1024;
        float ss = 0.f;
#pragma unroll
        for (int j = 0; j < 4; ++j) ss += (v[j].x * v[j].x + v[j].y * v[j].y) + (v[j].z * v[j].z + v[j].w * v[j].w);
        const float rstd = 1.0f / sqrtf(wave_sum(ss) * (1.0f / 1024.0f) + NORM_EPS);
        bf16* orow = F.HX() + (size_t)row * 1024;
#pragma unroll
        for (int j = 0; j < 4; ++j) { const int c0 = 4 * lane + 256 * j; const f32x4 s1 = *(const f32x4*)(sc + c0), s0 = *(const f32x4*)(sh + c0);
            v[j] = (v[j] * rstd * gn[j]) * (s1 + 1.0f) + s0;
            v2u o; o.x = pk2(v[j].x, v[j].y); o.y = pk2(v[j].z, v[j].w); *(GAS v2u*)(orow + c0) = o; }
        if (WHICH == 0) {
            float p[16];
#pragma unroll
            for (int cc = 0; cc < 16; ++cc) { float a = 0.f;
                if ((cc & 1) == 0) __builtin_amdgcn_sched_barrier(0);
#pragma unroll
                for (int j = 0; j < 4; ++j) { const f32x4 w = *(const LAS f32x4*)(wg + cc * 1028 + 4 * lane + 256 * j); a += (v[j].x * w.x + v[j].y * w.y) + (v[j].z * w.z + v[j].w * w.w); }
                p[cc] = a; }
            __builtin_amdgcn_sched_barrier(0);
            const bool b5 = lane & 32, b4 = lane & 16, b3 = lane & 8, b2 = lane & 4;
            float q8[8], q4[4], q2[2], q1;
#pragma unroll
            for (int i = 0; i < 8; ++i) { const float mine = b5 ? p[i + 8] : p[i], give = b5 ? p[i] : p[i + 8]; q8[i] = mine + __shfl_xor(give, 32); }
#pragma unroll
            for (int i = 0; i < 4; ++i) { const float mine = b4 ? q8[i + 4] : q8[i], give = b4 ? q8[i] : q8[i + 4]; q4[i] = mine + __shfl_xor(give, 16); }
#pragma unroll
            for (int i = 0; i < 2; ++i) { const float mine = b3 ? q4[i + 2] : q4[i], give = b3 ? q4[i] : q4[i + 2]; q2[i] = mine + __shfl_xor(give, 8); }
            { const float mine = b2 ? q2[1] : q2[0], give = b2 ? q2[0] : q2[1]; q1 = mine + __shfl_xor(give, 4); }
            q1 += __shfl_xor(q1, 1); q1 += __shfl_xor(q1, 2);
            const int oc = (b5 ? 8 : 0) + (b4 ? 4 : 0) + (b3 ? 2 : 0) + (b2 ? 1 : 0);
            if ((lane & 3) == 0) F.gatesf()[(size_t)row * 16 + oc] = q1 + F.b_in()[(size_t)l * DIN + 2048 + oc];
        }
#pragma unroll
        for (int j = 0; j < 4; ++j) v[j] = vn[j];
    }
#undef NORM_ROWPTR
    if (WHICH == 0) __syncthreads();
}
__device__ __forceinline__ void ph_rope(Frame& F, int l) {
    const int gw = F.vcu * NWAVES + F.wave, NGW = F.G * NWAVES;
    int lane_ = F.lane(); asm volatile("" : "+v"(lane_)); const int lane = lane_;
    const int c = lane & 7; const bool second = c & 2;
    const float* qn = F.qn_g() + l * 64; const float* kn = F.kn_g() + l * 64;
    const float C2 = 0.125f * 1.4426950408889634f;
    const float* rope = F.small() + SM_ROPE;
    for (int row = gw; row < ROWS; row += NGW) {
        const bool lat = row >= ROWS_CTX; const int t = (row - ROWS_CTX) & (SEQ - 1);
        f32x4 cs0 = {1.f, 1.f, 1.f, 1.f}, cs1 = cs0, sn0 = {0.f, 0.f, 0.f, 0.f}, sn1 = sn0;
        if (lat) { const int pos = (c & 4) ? (t & 63) : (t >> 6); const float* tb = rope + ((c & 4) ? 8192 : 0) + pos * 16 + 8 * (c & 1); const int so = (c & 4) ? 1024 : 4096;
            cs0 = *(const f32x4*)tb; cs1 = *(const f32x4*)(tb + 4); sn0 = *(const f32x4*)(tb + so); sn1 = *(const f32x4*)(tb + so + 4); }
        bf16* p[3]; bool donorm[3]; float scale[3]; const float* gn[3];
        p[0] = F.PROJ() + PJ_WQ + (size_t)row * 512 + lane * 8; donorm[0] = false; scale[0] = C2; gn[0] = qn;
        p[1] = F.PROJ() + PJ_GQ + (size_t)row * 512 + lane * 8; donorm[1] = true; scale[1] = C2; gn[1] = qn;
        p[2] = (lane < 16) ? F.PROJ() + PJ_WKV + (size_t)row * 256 + lane * 8 : F.PROJ() + PJ_GKV + (size_t)row * 256 + (lane & 15) * 8; donorm[2] = lane >= 16; scale[2] = 1.0f; gn[2] = kn;
        v4u x[3];
#pragma unroll
        for (int g = 0; g < 3; ++g) x[g] = (g < 2 || lane < 32) ? *(const GAS v4u*)p[g] : (v4u){0u, 0u, 0u, 0u};
#pragma unroll
        for (int g = 0; g < 3; ++g) {
            float e[8]; e[0] = __uint_as_float(x[g].x << 16); e[1] = __uint_as_float(x[g].x & 0xffff0000u); e[2] = __uint_as_float(x[g].y << 16); e[3] = __uint_as_float(x[g].y & 0xffff0000u);
            e[4] = __uint_as_float(x[g].z << 16); e[5] = __uint_as_float(x[g].z & 0xffff0000u); e[6] = __uint_as_float(x[g].w << 16); e[7] = __uint_as_float(x[g].w & 0xffff0000u);
            float ss = 0.f;
#pragma unroll
            for (int i = 0; i < 8; ++i) ss += e[i] * e[i];
            ss += __shfl_xor(ss, 1); ss += __shfl_xor(ss, 2); ss += __shfl_xor(ss, 4);
            if (donorm[g]) { const float r = 1.0f / sqrtf(ss * (1.0f / 64.0f) + NORM_EPS); const f32x4 g0 = *(const f32x4*)(gn[g] + 8 * c), g1 = *(const f32x4*)(gn[g] + 8 * c + 4);
                e[0] *= r * g0.x; e[1] *= r * g0.y; e[2] *= r * g0.z; e[3] *= r * g0.w; e[4] *= r * g1.x; e[5] *= r * g1.y; e[6] *= r * g1.z; e[7] *= r * g1.w; }
            float o[8];
#pragma unroll
            for (int i = 0; i < 8; ++i) { const float pr = __shfl_xor(e[i], 2); const float cs = i < 4 ? cs0[i & 3] : cs1[i & 3], sn = i < 4 ? sn0[i & 3] : sn1[i & 3];
                o[i] = (second ? (pr * sn + e[i] * cs) : (e[i] * cs - pr * sn)) * scale[g]; }
            v4u w; w.x = pk2(o[0], o[1]); w.y = pk2(o[2], o[3]); w.z = pk2(o[4], o[5]); w.w = pk2(o[6], o[7]);
            if (g < 2 || lane < 32) *(GAS v4u*)p[g] = w;
        }
    }
}

__device__ __forceinline__ float log_sigmoid_f(float x) { return fminf(x, 0.f) - log1pf(expf(-fabsf(x))); }
__device__ __forceinline__ int crow16(int r, int hi) { return (r & 3) + 8 * (r >> 2) + 4 * hi; }
__device__ __forceinline__ s16x4 tr_read(const LAS unsigned char* p) {
    typedef short v4i16_t __attribute__((ext_vector_type(4)));
    return __builtin_bit_cast(s16x4, __builtin_amdgcn_ds_read_tr16_b64_v4i16((LAS v4i16_t*)p));
}
__device__ __forceinline__ bf16x8 cat8(s16x4 lo, s16x4 hi) { return (bf16x8){lo[0], lo[1], lo[2], lo[3], hi[0], hi[1], hi[2], hi[3]}; }
__device__ __forceinline__ unsigned scale_pk(unsigned u, float w) { return pk2(__uint_as_float(u << 16) * w, __uint_as_float(u & 0xffff0000u) * w); }
__device__ __forceinline__ int chunk_row0(int b, int cidx) { return cidx < 2 ? b * 256 + cidx * 128 : ROWS_CTX + b * SEQ + (cidx - 2) * 128; }
__device__ __forceinline__ int chain_order(int dir, int j) { return dir == 0 ? j : (j < 2 ? 1 - j : 131 - j); }
template <bool OUT> __device__ __forceinline__ void ml_gates(const float* gatesf, int row0, int dir, int h, float m_before, LAS float* A0, LAS float* A1, LAS float* A2, LAS float* A3, int lane, float& b_end, float& G_end) {
    const int tA = dir ? 127 - lane : lane, tB = dir ? 63 - lane : 64 + lane;
    const float iA = gatesf[(size_t)(row0 + tA) * 16 + dir * 4 + h], fA = gatesf[(size_t)(row0 + tA) * 16 + 8 + dir * 4 + h];
    const float iB = gatesf[(size_t)(row0 + tB) * 16 + dir * 4 + h], fB = gatesf[(size_t)(row0 + tB) * 16 + 8 + dir * 4 + h];
    float sA = log_sigmoid_f(fA), sB = log_sigmoid_f(fB);
#pragma unroll
    for (int o = 1; o < 64; o <<= 1) { const float a = __shfl_up(sA, o), b = __shfl_up(sB, o); if (lane >= o) { sA += a; sB += b; } }
    sB += __shfl(sA, 63);
    const float gA = iA - sA, gB = iB - sB;
    float mA = gA, mB = gB;
#pragma unroll
    for (int o = 1; o < 64; o <<= 1) { const float a = __shfl_up(mA, o), b = __shfl_up(mB, o); if (lane >= o) { mA = fmaxf(mA, a); mB = fmaxf(mB, b); } }
    mB = fmaxf(mB, __shfl(mA, 63));
    b_end = __shfl(sB, 63); G_end = __shfl(mB, 63);
    if (!OUT) { A0[tA] = expf(gA - G_end); A0[tB] = expf(gB - G_end); }
    else { const float qscale = 0.08838834764831845f;
        const float muA = fmaxf(m_before, mA), muB = fmaxf(m_before, mB);
        A0[tA] = gA; A1[tA] = muA; A2[tA] = expf(m_before - muA) * qscale; A3[tA] = expf(-(sA + muA));
        A0[tB] = gB; A1[tB] = muB; A2[tB] = expf(m_before - muB) * qscale; A3[tB] = expf(-(sB + muB)); }
}
__device__ __forceinline__ void ml_local_unit(Frame& F, int b, int dir, int h, int cidx) {
    LAS unsigned char* Kt = F.lds; LAS unsigned char* Vx = F.lds + 40960; LAS float* wk = (LAS float*)(F.lds + 81920);
    const int row0 = chunk_row0(b, cidx), chain = (b * 2 + dir) * 4 + h;
    const int lane = F.lane(), r32 = lane & 31, hi = lane >> 5;
    if (F.wave == 0) { float be, ge; ml_gates<false>(F.gatesf(), row0, dir, h, 0.f, wk, wk, wk, wk, lane, be, ge);
        if (lane == 0) { F.small()[SM_SC + (chain * NCHUNK + cidx) * 2] = be; F.small()[SM_SC + (chain * NCHUNK + cidx) * 2 + 1] = ge; } }
    __syncthreads();
    const bf16* mlk = F.PROJ() + PJ_MLK + (size_t)row0 * 512 + h * 128; const bf16* mlv = F.PROJ() + PJ_MLV + (size_t)row0 * 512 + h * 128;
#pragma unroll
    for (int i = 0; i < 4; ++i) { const int id = F.tid + 512 * i, row = id >> 4, ch = id & 15;
        v4u kv = *(const GAS v4u*)(mlk + (size_t)row * 512 + ch * 8); const float w = wk[row];
        kv.x = scale_pk(kv.x, w); kv.y = scale_pk(kv.y, w); kv.z = scale_pk(kv.z, w); kv.w = scale_pk(kv.w, w);
        *(LAS v4u*)(Kt + row * 320 + ch * 16) = kv;
        *(LAS v4u*)(Vx + row * 320 + ch * 16) = *(const GAS v4u*)(mlv + (size_t)row * 512 + ch * 8); }
    if (F.tid < 128) { LAS v4u* p = (LAS v4u*)(Vx + F.tid * 320 + 256); p[0] = (v4u){0x00003F80u, 0u, 0u, 0u}; p[1] = (v4u){0u, 0u, 0u, 0u}; p[2] = p[1]; p[3] = p[1]; }
    __syncthreads();
    const int dkt = F.wave & 3, half = F.wave >> 2;
    const int g = (lane >> 4) & 1, q = (lane & 15) >> 2, p4 = lane & 3;
    const LAS unsigned char* kbase = Kt + (8 * hi + q) * 320 + (dkt * 32 + 16 * g + 4 * p4) * 2;
    const LAS unsigned char* vbase = Vx + (8 * hi + q) * 320 + (16 * g + 4 * p4) * 2;
    f32x16 acc0 = {}, acc1 = {}, acc2 = {};
    const int dv0 = half ? 2 : 0;
#pragma unroll
    for (int ks = 0; ks < 8; ++ks) {
        const bf16x8 Bf = cat8(tr_read(kbase + ks * 16 * 320), tr_read(kbase + ks * 16 * 320 + 4 * 320));
        const bf16x8 A0 = cat8(tr_read(vbase + ks * 16 * 320 + dv0 * 64), tr_read(vbase + ks * 16 * 320 + 4 * 320 + dv0 * 64));
        const bf16x8 A1 = cat8(tr_read(vbase + ks * 16 * 320 + (dv0 + 1) * 64), tr_read(vbase + ks * 16 * 320 + 4 * 320 + (dv0 + 1) * 64));
        acc0 = __builtin_amdgcn_mfma_f32_32x32x16_bf16(A0, Bf, acc0, 0, 0, 0);
        acc1 = __builtin_amdgcn_mfma_f32_32x32x16_bf16(A1, Bf, acc1, 0, 0, 0);
        if (half == 0) { const bf16x8 A2 = cat8(tr_read(vbase + ks * 16 * 320 + 4 * 64), tr_read(vbase + ks * 16 * 320 + 4 * 320 + 4 * 64));
            acc2 = __builtin_amdgcn_mfma_f32_32x32x16_bf16(A2, Bf, acc2, 0, 0, 0); }
    }
    bf16* slot = F.ST() + (size_t)(chain * NCHUNK + cidx) * ST_SLOT + dkt * 32 + r32;
#pragma unroll
    for (int r = 0; r < 16; ++r) { const int dr = crow16(r, hi);
        slot[(size_t)(dv0 * 32 + dr) * 128] = (bf16)f2bf(acc0[r]); slot[(size_t)((dv0 + 1) * 32 + dr) * 128] = (bf16)f2bf(acc1[r]); }
    if (half == 0 && hi == 0) slot[(size_t)128 * 128] = (bf16)f2bf(acc2[0]);
    __syncthreads();
}
__device__ __forceinline__ void ph_scan(Frame& F, const bool dummy) {
    LAS float* cA = (LAS float*)F.lds; LAS float* cB = cA + 132; LAS float* cM = cB + 132; LAS float* sc = cM + 132;
    for (int item = F.vcu; item < 256; item += F.G) {
        const int chain = item >> 4, part = item & 15, dir = (chain >> 2) & 1;
        __syncthreads();
        if (F.tid < 2 * NCHUNK) sc[F.tid] = F.small()[SM_SC + chain * 2 * NCHUNK + F.tid];
        __syncthreads();
        if (F.tid == 0) { float m = 0.f;
            for (int j = 0; j < NCHUNK; ++j) { const int s = chain_order(dir, j); const float be = sc[2 * s], ge = sc[2 * s + 1], mx = fmaxf(m, ge);
                cA[j] = expf(m - mx); cB[j] = expf(ge - mx); cM[j] = m; m = be + mx; } }
        __syncthreads();
        if (part == 0 && F.tid < NCHUNK) F.small()[SM_MB + chain * NCHUNK + chain_order(dir, F.tid)] = cM[F.tid];
        bf16* base = F.ST() + (size_t)chain * NCHUNK * ST_SLOT; bf16* wbase = dummy ? F.MERGED() + (size_t)(chain & 1) * NCHUNK * ST_SLOT : base;
        const int off = (8 * part + (F.tid >> 6)) * 128 + 2 * (F.tid & 63), offx = 128 * 128 + 2 * (F.tid & 63);
        const bool hasx = (part == 0) && (F.wave == 0);
        float s0 = 0.f, s1 = 0.f, x0 = 0.f, x1 = 0.f;
        unsigned q[8], qx[8];
#pragma unroll
        for (int k = 0; k < 8; ++k) { q[k] = *(const GAS unsigned*)(base + (size_t)chain_order(dir, k) * ST_SLOT + off); qx[k] = hasx ? *(const GAS unsigned*)(base + (size_t)chain_order(dir, k) * ST_SLOT + offx) : 0u; }
        for (int j0 = 0; j0 < NCHUNK; j0 += 8) {
#pragma unroll
            for (int k = 0; k < 8; ++k) { const int j = j0 + k;
                if (j < NCHUNK) {
                    const unsigned cur = q[k], curx = qx[k]; const size_t so = (size_t)chain_order(dir, j) * ST_SLOT;
                    if (j + 8 < NCHUNK) { const size_t sn = (size_t)chain_order(dir, j + 8) * ST_SLOT; q[k] = *(const GAS unsigned*)(base + sn + off); if (hasx) qx[k] = *(const GAS unsigned*)(base + sn + offx); }
                    const float a = cA[j], bb = cB[j];
                    *(GAS unsigned*)(wbase + so + off) = pk2(s0, s1);
                    s0 = a * s0 + bb * __uint_as_float(cur << 16); s1 = a * s1 + bb * __uint_as_float(cur & 0xffff0000u);
                    if (hasx) { *(GAS unsigned*)(wbase + so + offx) = pk2(x0, x1); x0 = a * x0 + bb * __uint_as_float(curx << 16); x1 = a * x1 + bb * __uint_as_float(curx & 0xffff0000u); }
                } }
        }
    }
}
__device__ __forceinline__ void ml_out_unit(Frame& F, int l, int b, int h, int cidx, bf16* ybase) {
    LAS unsigned char* Kt = F.lds;
    LAS unsigned char* Vx = F.lds + 34816;
    LAS unsigned char* Ct = F.lds + 75776;
    LAS float* hs = (LAS float*)(F.lds + 75776);
    LAS float* scal = (LAS float*)(F.lds + 141824);
    constexpr int CT_DIR = 129 * 256, CT_CHUNKS = 129 * 16;
    const int row0 = chunk_row0(b, cidx);
    int tid_ = F.tid; asm volatile("" : "+v"(tid_));
    const int tid = tid_, lane = tid & 63, r32 = lane & 31, hi = lane >> 5;
    const int tt = F.wave & 3, dir = F.wave >> 2, tl = tt * 32 + r32;
    const bf16* mlk = F.PROJ() + PJ_MLK + (size_t)row0 * 512 + h * 128; const bf16* mlv = F.PROJ() + PJ_MLV + (size_t)row0 * 512 + h * 128;
    const bf16* mlq = F.PROJ() + PJ_MLQ + (size_t)row0 * 512 + h * 128; bf16* yq = ybase + (size_t)row0 * 512 + h * 128; const bf16* mlo = F.PROJ() + PJ_MLO + (size_t)row0 * 512 + h * 128;
    v4u kr[4], vr[4], cr[9], qu[8];
#pragma unroll
    for (int i = 0; i < 4; ++i) { const int id = tid + 512 * i, row = id >> 4, ch = id & 15; kr[i] = *(const GAS v4u*)(mlk + (size_t)row * 512 + ch * 8); vr[i] = *(const GAS v4u*)(mlv + (size_t)row * 512 + ch * 8); }
#pragma unroll
    for (int i = 0; i < 9; ++i) { const int c = tid + 512 * i;
        if (i < 8 || tid < 2 * CT_CHUNKS - 4096) { const int d = c >= CT_CHUNKS ? 1 : 0, rem = c - d * CT_CHUNKS, row = rem >> 4, ch = rem & 15;
            cr[i] = *(const GAS v4u*)(F.ST() + (size_t)(((b * 2 + d) * 4 + h) * NCHUNK + cidx) * ST_SLOT + (size_t)row * 128 + ch * 8); } else cr[i] = (v4u){0u, 0u, 0u, 0u}; }
#pragma unroll
    for (int ks = 0; ks < 8; ++ks) qu[ks] = *(const GAS v4u*)(mlq + (size_t)tl * 512 + ks * 16 + hi * 8);
    if (F.wave < 2) { const int d = F.wave, chain = (b * 2 + d) * 4 + h; const float mb = F.small()[SM_MB + chain * NCHUNK + cidx]; float be, ge; LAS float* S = scal + d * 512;
        ml_gates<true>(F.gatesf(), row0, d, h, mb, S, S + 128, S + 256, S + 384, lane, be, ge); }
#pragma unroll
    for (int i = 0; i < 4; ++i) { const int id = tid + 512 * i, row = id >> 4, ch = id & 15; *(LAS v4u*)(Kt + row * 272 + ch * 16) = kr[i]; *(LAS v4u*)(Vx + row * 320 + ch * 16) = vr[i]; }
    if (tid < 128) { LAS v4u* p = (LAS v4u*)(Vx + tid * 320 + 256); v4u one = (v4u){0x00003F80u, 0u, 0u, 0u}, zz = (v4u){0u, 0u, 0u, 0u}; asm volatile("" : "+v"(one), "+v"(zz)); p[0] = one; p[1] = zz; p[2] = zz; p[3] = zz; }
#pragma unroll
    for (int i = 0; i < 9; ++i) { const int c = tid + 512 * i;
        if (i < 8 || tid < 2 * CT_CHUNKS - 4096) { const int d = c >= CT_CHUNKS ? 1 : 0, rem = c - d * CT_CHUNKS, row = rem >> 4, ch = rem & 15;
            *(LAS v4u*)(Ct + d * CT_DIR + row * 256 + ((ch ^ (row & 15)) << 4)) = cr[i]; } }
    __syncthreads();
    unsigned hpk[4][8];
    {
        const LAS float* Sg = scal + dir * 512; const LAS float* Smu = Sg + 128; const LAS float* Sa = Sg + 256; const LAS float* Sfl = Sg + 384;
        const float mu_t = Smu[tl];
        const float qscale = 0.08838834764831845f;
        bf16x8 pa[4][2];
#pragma unroll
        for (int st = 0; st < 4; ++st) {
            const bool valid = dir == 0 ? (st <= tt) : (st >= tt);
            if (valid) {
                f32x16 acc = {};
#pragma unroll
                for (int ks = 0; ks < 8; ++ks) { const bf16x8 kf = *(const LAS bf16x8*)(Kt + (st * 32 + r32) * 272 + (ks * 16 + hi * 8) * 2); acc = __builtin_amdgcn_mfma_f32_32x32x16_bf16(kf, __builtin_bit_cast(bf16x8, qu[ks]), acc, 0, 0, 0); }
                float pv[16];
#pragma unroll
                for (int r = 0; r < 16; ++r) { const int s = st * 32 + crow16(r, hi); const float w = __builtin_amdgcn_exp2f((Sg[s] - mu_t) * 1.4426950408889634f); const bool ok = dir == 0 ? (s <= tl) : (s >= tl); pv[r] = ok ? acc[r] * qscale * w : 0.f; }
                v4u p0, p1; p0.x = pk2(pv[0], pv[1]); p0.y = pk2(pv[2], pv[3]); p0.z = pk2(pv[4], pv[5]); p0.w = pk2(pv[6], pv[7]);
                p1.x = pk2(pv[8], pv[9]); p1.y = pk2(pv[10], pv[11]); p1.z = pk2(pv[12], pv[13]); p1.w = pk2(pv[14], pv[15]);
                pa[st][0] = __builtin_bit_cast(bf16x8, p0); pa[st][1] = __builtin_bit_cast(bf16x8, p1);
            } else { pa[st][0] = (bf16x8){0, 0, 0, 0, 0, 0, 0, 0}; pa[st][1] = pa[st][0]; }
        }
        const int g = (lane >> 4) & 1, q = (lane & 15) >> 2, p4 = lane & 3;
        const LAS unsigned char* vbase = Vx + (4 * hi + q) * 320 + (16 * g + 4 * p4) * 2;
        const LAS unsigned char* cdir = Ct + dir * CT_DIR;
        float inv[16], arow[16];
#pragma unroll
        for (int r = 0; r < 16; ++r) arow[r] = Sa[tt * 32 + crow16(r, hi)];
#pragma unroll
        for (int di = 0; di < 5; ++di) { const int dvt = di == 0 ? 4 : di - 1;
            __builtin_amdgcn_sched_barrier(0);
            f32x16 acc = {};
#pragma unroll
            for (int st = 0; st < 4; ++st) { const bool valid = dir == 0 ? (st <= tt) : (st >= tt);
                if (valid) {
#pragma unroll
                    for (int k2 = 0; k2 < 2; ++k2) { const int sb = st * 32 + 16 * k2;
                        const bf16x8 Bf = cat8(tr_read(vbase + sb * 320 + dvt * 64), tr_read(vbase + (sb + 8) * 320 + dvt * 64));
                        acc = __builtin_amdgcn_mfma_f32_32x32x16_bf16(pa[st][k2], Bf, acc, 0, 0, 0); } } }
            const int dvr = min(dvt * 32 + r32, 128), sw = dvr & 15; const LAS unsigned char* crow_p = cdir + dvr * 256;
            f32x16 acc2 = {};
#pragma unroll
            for (int ks = 0; ks < 8; ++ks) { const bf16x8 Bf = *(const LAS bf16x8*)(crow_p + (((2 * ks + hi) ^ sw) << 4)); acc2 = __builtin_amdgcn_mfma_f32_32x32x16_bf16(__builtin_bit_cast(bf16x8, qu[ks]), Bf, acc2, 0, 0, 0); }
            if (di == 0) {
#pragma unroll
                for (int r = 0; r < 16; ++r) { const int tr = tt * 32 + crow16(r, hi); const float den = __shfl(acc[r] + arow[r] * acc2[r], lane & 32); inv[r] = __builtin_amdgcn_rcpf(fmaxf(fabsf(den), Sfl[tr])); }
            } else {
#pragma unroll
                for (int r = 0; r < 16; r += 2) hpk[di - 1][r >> 1] = pk2((acc[r] + arow[r] * acc2[r]) * inv[r], (acc[r + 1] + arow[r + 1] * acc2[r + 1]) * inv[r + 1]);
            }
        }
    }
    __syncthreads();
    const int frow = tid >> 2, fqd = tid & 3;
    v4u og[4];
#pragma unroll
    for (int c = 0; c < 4; ++c) og[c] = *(const GAS v4u*)(mlo + (size_t)frow * 512 + fqd * 32 + 8 * c);
    if (dir == 0) {
#pragma unroll
        for (int dt = 0; dt < 4; ++dt)
#pragma unroll
            for (int r = 0; r < 16; ++r) hs[(tt * 32 + crow16(r, hi)) * 128 + dt * 32 + r32] = (r & 1) ? __uint_as_float(hpk[dt][r >> 1] & 0xffff0000u) : __uint_as_float(hpk[dt][r >> 1] << 16);
    }
    __syncthreads();
    if (dir == 1) {
#pragma unroll
        for (int dt = 0; dt < 4; ++dt)
#pragma unroll
            for (int r = 0; r < 16; ++r) hs[(tt * 32 + crow16(r, hi)) * 128 + dt * 32 + r32] += (r & 1) ? __uint_as_float(hpk[dt][r >> 1] & 0xffff0000u) : __uint_as_float(hpk[dt][r >> 1] << 16);
    }
    __syncthreads();
    {
        const float* gn = F.ml_norm_g() + (size_t)(l * 4 + h) * 128;
        const LAS f32x4* hp = (const LAS f32x4*)(hs + frow * 128 + fqd * 32);
        f32x4 hv[8]; float ss = 0.f;
#pragma unroll
        for (int j = 0; j < 8; ++j) { hv[j] = hp[j]; ss += (hv[j].x * hv[j].x + hv[j].y * hv[j].y) + (hv[j].z * hv[j].z + hv[j].w * hv[j].w); }
        ss += __shfl_xor(ss, 1); ss += __shfl_xor(ss, 2);
        const float r = 1.0f / sqrtf(ss * (1.0f / 128.0f) + NORM_EPS);
        GAS v4u* yp = (GAS v4u*)(yq + (size_t)frow * 512 + fqd * 32);
#pragma unroll
        for (int c = 0; c < 4; ++c) { const v4u ou = og[c]; const f32x4 ga = *(const f32x4*)(gn + fqd * 32 + 8 * c), gb = *(const f32x4*)(gn + fqd * 32 + 8 * c + 4);
            const f32x4 a = hv[2 * c], bq = hv[2 * c + 1]; v4u o;
            o.x = pk2(a.x * r * ga.x * pg8::fast_sigmoid(__uint_as_float(ou.x << 16)), a.y * r * ga.y * pg8::fast_sigmoid(__uint_as_float(ou.x & 0xffff0000u)));
            o.y = pk2(a.z * r * ga.z * pg8::fast_sigmoid(__uint_as_float(ou.y << 16)), a.w * r * ga.w * pg8::fast_sigmoid(__uint_as_float(ou.y & 0xffff0000u)));
            o.z = pk2(bq.x * r * gb.x * pg8::fast_sigmoid(__uint_as_float(ou.z << 16)), bq.y * r * gb.y * pg8::fast_sigmoid(__uint_as_float(ou.z & 0xffff0000u)));
            o.w = pk2(bq.z * r * gb.z * pg8::fast_sigmoid(__uint_as_float(ou.w << 16)), bq.w * r * gb.w * pg8::fast_sigmoid(__uint_as_float(ou.w & 0xffff0000u)));
            yp[c] = o; }
    }
    __syncthreads();
}

__device__ __forceinline__ void ph_mixers(Frame& F, int l, unsigned char* lds_generic, const int dup) {
    using attn_body::AttnArgs; using attn_body::attn_unit;
#ifndef MIX_ONLY
#define MIX_ONLY -1
#endif
    if ((MIX_ONLY < 0 || MIX_ONLY == 0) && !(DBG_NAIVE_BITS & 1) && (dup == 0 || (dup & 1))) {
        const int c_lo = (l == 0) ? 0 : 2, ncz = NCHUNK - c_lo, nunits = 8 * ncz;
        for (int u = F.vcu; u < nunits; u += F.G) { const int bh = u / ncz, cidx = c_lo + u % ncz; ml_out_unit(F, l, bh >> 2, bh & 3, cidx, dup ? F.MERGED() : F.PROJ() + PJ_MLQ); }
    }
    const float L2E = 1.4426950408889634f;
    float score_bound;
    { float qm = fabsf(F.qn_g()[l * 64 + F.lane()]), km = fabsf(F.kn_g()[l * 64 + F.lane()]);
#pragma unroll
      for (int o = 1; o < 64; o <<= 1) { qm = fmaxf(qm, __shfl_xor(qm, o)); km = fmaxf(km, __shfl_xor(km, o)); }
      const unsigned sbu = __builtin_amdgcn_readfirstlane(__float_as_uint(64.0f * 0.125f * L2E * 1.01f * qm * km)); score_bound = __uint_as_float(sbu); }
    typedef attn_body::bf16 abf;
    abf* P = (abf*)F.PROJ();
    for (int pass = 0; pass < 2; ++pass)
        for (int u = F.vcu; u < 1024; u += F.G) {
            const int combo = (u >> 6) & 3, hq = u >> 8, qb = u & 63;
            const int b = combo >> 1, g = combo & 1, h = g * 4 + hq;
            AttnArgs A;
            A.pq = 512; A.pkv = 256; A.qrow0 = ROWS_CTX + b * SEQ + qb * 256; A.ctxrow0 = b * 256; A.latrow0 = ROWS_CTX + b * SEQ; A.q0 = qb * 256;
            if (MIX_ONLY >= 0 && MIX_ONLY != 1 + pass) continue;
            if (DBG_NAIVE_BITS & (pass == 0 ? 2 : 4)) continue;
            if (dup != 0 && !(dup & (pass == 0 ? 2 : 4))) continue;
            if (pass == 0) { A.Q = P + PJ_WQ + h * 64; A.K = P + PJ_WKV + g * 64; A.V = A.K + 128; A.O = (abf*)A.Q; A.sink_l2 = F.win_sink()[l * 8 + h] * L2E; if (dup) A.O = (abf*)F.MERGED() + h * 64;
                attn_unit<1, 8>(A, (char*)lds_generic); }
            else { A.Q = P + PJ_GQ + h * 64; A.K = P + PJ_GKV + g * 64; A.V = A.K + 128; A.O = (abf*)A.Q; A.sink_l2 = -INFINITY; if (dup) A.O = (abf*)F.MERGED() + h * 64;
                if (score_bound <= 40.0f) attn_unit<3, 8>(A, (char*)lds_generic); else attn_unit<0, 8>(A, (char*)lds_generic); }
        }
    if (l == 0 && (MIX_ONLY < 0 || MIX_ONLY == 3) && (dup == 0 || (dup & 8)))
        for (int u = F.vcu - (F.G - 32); u >= 0 && u < 32; u += F.G) {
            const int br = u >> 4, b = (u >> 3) & 1, h = u & 7, g = h >> 2;
            if (DBG_NAIVE_BITS & (br == 0 ? 2 : 4)) continue;
            AttnArgs A;
            A.pq = 512; A.pkv = 256; A.qrow0 = b * 256; A.ctxrow0 = b * 256; A.latrow0 = 0; A.q0 = 0;
            A.Q = P + (br ? PJ_GQ : PJ_WQ) + h * 64; A.K = P + (br ? PJ_GKV : PJ_WKV) + g * 64; A.V = A.K + 128; A.O = (abf*)A.Q;
            A.sink_l2 = br ? -INFINITY : F.win_sink()[l * 8 + h] * L2E; if (dup) A.O = (abf*)F.MERGED() + h * 64;
            attn_unit<2, 8>(A, (char*)lds_generic);
        }
}
__device__ __forceinline__ void ph_final(Frame& F, const bool dummy) {
    const int gw = F.vcu * NWAVES + F.wave, NGW = F.G * NWAVES; const int lane = F.lane();
    f32x4 g[4];
#pragma unroll
    for (int j = 0; j < 4; ++j) g[j] = *(const f32x4*)(F.final_g() + 4 * lane + 256 * j);
    for (int row0 = gw; row0 < ROWS_LAT; row0 += 4 * NGW) {
        f32x4 v[4][4];
#pragma unroll
        for (int q = 0; q < 4; ++q) { const int row = row0 + q * NGW; if (row < ROWS_LAT) { const float* xr = F.out() + (size_t)row * 1024;
#pragma unroll
                for (int j = 0; j < 4; ++j) v[q][j] = *(const f32x4*)(xr + 4 * lane + 256 * j); } }
#pragma unroll
        for (int q = 0; q < 4; ++q) { const int row = row0 + q * NGW; if (row < ROWS_LAT) { float ss = 0.f;
#pragma unroll
                for (int j = 0; j < 4; ++j) ss += (v[q][j].x * v[q][j].x + v[q][j].y * v[q][j].y) + (v[q][j].z * v[q][j].z + v[q][j].w * v[q][j].w);
                const float rstd = 1.0f / sqrtf(wave_sum(ss) * (1.0f / 1024.0f) + NORM_EPS);
                float* xo = dummy ? (float*)F.HX() + (size_t)(row & 8191) * 1024 : F.out() + (size_t)row * 1024;
#pragma unroll
                for (int j = 0; j < 4; ++j) *(f32x4*)(xo + 4 * lane + 256 * j) = v[q][j] * rstd * g[j]; } }
    }
}

#ifdef ONLY_PHASE
#define IN(k) (((k) == ONLY_PHASE) || ((k) == ONLY_PHASE + 11 && ONLY_PHASE > 0 && ONLY_PHASE < 12))
#else
#define IN(k) (lo <= (k) && (k) < hi)
#endif
#define SEAM(k) do { if (IN((k) + 1)) { xcd_barrier(bar); if (DBG_BAR2) xcd_barrier(bar); } } while (0)
#define STAGGER(us) do { if ((us) > 0 && (F.vcu & 1)) { const unsigned long long t0_ = __builtin_amdgcn_s_memrealtime(); while (__builtin_amdgcn_s_memrealtime() - t0_ < (unsigned long long)((us) * 100)) __builtin_amdgcn_s_sleep(8); } __syncthreads(); } while (0)
#define REP(bit) _Pragma("unroll") for (int rep_ = 0; rep_ < ((DBG_DUP & (bit)) ? 2 : 1); ++rep_)
#define REPGAIN(bit) (((DBG_DUP & (bit)) && rep_ == 0) ? 0.0f : 1.0f)
template <int l> __device__ __forceinline__ void layer_phases(Frame& F, const int lo, const int hi, const XcdBarrier& bar, unsigned char* lds) {
        const int pb = 1 + 11 * l;
        const int r0 = 0;
        const int r0b = (l == 1) ? ROWS_CTX : 0;
        const float* modl = F.small() + SM_MODV + l * 3 * 6144;
        if (IN(pb + 0)) { REP(1) { ph_norm<0>(F, l, 0); } SEAM(pb + 0); }
        if (IN(pb + 1)) { STAGGER(DBG_STG_PROJ); REP(2) { pg8::Gemm g{F.HX(), F.W(l) + W_P, ROWS, NPROJ, 1024}; pg8::StaticOrder S; S.init(ROWS, NPROJ, F.G, (int)blockIdx.x);
            pg8::EpiProj E{F.PROJ(), F.biasP(l)};
            pg8::gemm_phase<pg8::EpiProj, pg8::StaticOrder, true, true>(F.lds, g, S, E);
            if (l == 0) {
                pg8::Gemm g2{F.HX(), F.W(l) + W_G, ROWS_CTX, NGATE, 1024}; pg8::TailOrder S2; { const int nwg = (ROWS / 256) * (NPROJ / 256), c0 = nwg % F.G, nt2 = (ROWS_CTX / 256) * (NGATE / 256); S2.init(ROWS_CTX, NGATE, (c0 + nt2 <= F.G) ? c0 : 0, (int)blockIdx.x); }
                pg8::EpiGate E2{F.GSCTX(), NGATE, F.biasG(l), 0};
                pg8::gemm_phase<pg8::EpiGate, pg8::TailOrder, true, true>(F.lds, g2, S2, E2); } } SEAM(pb + 1); }
        if (IN(pb + 2)) { ph_rope(F, l);
            REP(4) for (int u = F.vcu; u < 16 * NCHUNK; u += F.G) { const int chain = u / NCHUNK, cidx = u % NCHUNK; ml_local_unit(F, chain >> 3, (chain >> 2) & 1, chain & 3, cidx); }
            SEAM(pb + 2); }
        if (IN(pb + 3)) { if (DBG_DUP & 0x4000) ph_scan(F, true); ph_scan(F, false); SEAM(pb + 3); }
        if (IN(pb + 4)) { if (DBG_DUP & 0x1E00) ph_mixers(F, l, lds, (DBG_DUP >> 9) & 15); ph_mixers(F, l, lds, 0); SEAM(pb + 4); }
        bf16* Gs = F.PROJ() + PJ_MLK;
        if (IN(pb + 5)) { STAGGER(DBG_STG_GATES); REP(8) { pg8::Gemm g{F.HX() + (size_t)ROWS_CTX * 1024, F.W(l) + W_G, ROWS_LAT, NGATE, 1024}; pg8::StaticOrder S; S.init(ROWS_LAT, NGATE, F.G, (int)blockIdx.x);
            pg8::EpiGate E{Gs, NGATE, F.biasG(l), ROWS_CTX};
            pg8::gemm_phase<pg8::EpiGate, pg8::StaticOrder, true, true>(F.lds, g, S, E); } SEAM(pb + 5); }
        if (IN(pb + 6)) { STAGGER(DBG_STG_MERGE); REP(16) {
            _Pragma("unroll") for (int br = 0; br < 3; ++br) {
                pg8::Gemm g{F.PROJ() + PJ_MLQ + (size_t)br * A512 + (size_t)r0b * 512, F.W(l) + W_BR + (size_t)br * 1024 * 512, ROWS - r0b, 1024, 512, 0, 0};
                pg8::StaticOrder S; S.init(ROWS - r0b, 1024, F.G, (int)blockIdx.x);
                pg8::EpiMerge<true> E{Gs + br * 1024, F.GSCTX() + br * 1024, NGATE, F.MERGED(), r0b, 1.0f, br}; pg8::gemm_phase<pg8::EpiMerge<true>, pg8::StaticOrder, true, true>(F.lds, g, S, E); } }
            SEAM(pb + 6); }
        if (IN(pb + 7)) { STAGGER(DBG_STG_WO); REP(32) { pg8::Gemm g{F.MERGED() + (size_t)r0b * 1024, F.W(l) + W_O, ROWS - r0b, 1024, 1024}; pg8::StaticOrder S; S.init(ROWS - r0b, 1024, F.G, (int)blockIdx.x);
            pg8::EpiResid E{l == 0 ? F.ctx() : F.xc(), l == 0 ? F.x() : F.out(), F.xc(), F.out(), modl + 2048, r0b, REPGAIN(32)};
            pg8::gemm_phase<pg8::EpiResid, pg8::StaticOrder, true, true>(F.lds, g, S, E); } SEAM(pb + 7); }
        if (IN(pb + 8)) { REP(64) ph_norm<1>(F, l, r0b); SEAM(pb + 8); }
        bf16* Hb = F.PROJ();
        if (IN(pb + 9)) { STAGGER(DBG_STG_FFN1); REP(128) { pg8::Gemm g{F.HX() + (size_t)r0b * 1024, F.W(l) + W_13, ROWS - r0b, 5632, 1024}; pg8::StaticOrder S; S.init(ROWS - r0b, 5632, F.G, (int)blockIdx.x);
            pg8::EpiFFN1 E{Hb, r0b};
            pg8::gemm_phase<pg8::EpiFFN1, pg8::StaticOrder, true, true>(F.lds, g, S, E); } SEAM(pb + 9); }
        if (IN(pb + 10)) { STAGGER(DBG_STG_FFN2); REP(256) { pg8::Gemm g{Hb + (size_t)r0b * DFF, F.W(l) + W_2, ROWS - r0b, 1024, DFF}; pg8::StaticOrder S; S.init(ROWS - r0b, 1024, F.G, (int)blockIdx.x);
            pg8::EpiResid E{F.xc(), F.out(), F.xc(), F.out(), modl + 5120, r0b, REPGAIN(256)};
            pg8::gemm_phase<pg8::EpiResid, pg8::StaticOrder, true, true>(F.lds, g, S, E); } SEAM(pb + 10); }
        (void)r0;
}
__global__ void __launch_bounds__(NWAVES * 64, 2) fwd_kernel(Args args) {
    extern __shared__ __attribute__((aligned(16))) unsigned char lds[];
    Frame F{args};
    F.lds = (LAS unsigned char*)lds;
    F.MISC = (volatile LAS unsigned*)(F.lds + MISC_OFF);
    F.tid = threadIdx.x; F.wave = __builtin_amdgcn_readfirstlane(F.tid >> 6);
    F.G = gridDim.x; { const int bx = blockIdx.x; F.vcu = (F.G % 8 == 0) ? (bx % 8) * (F.G / 8) + bx / 8 : bx; }
    for (int u = F.tid; u < 32; u += NWAVES * 64) ((LAS unsigned*)(F.lds + MISC_OFF))[u] = 0u;
    __syncthreads();
    const int lo = args.ph_lo, hi = args.ph_hi;
    const bool use_bar = (hi - lo) > 1;
    XcdBarrier bar; bar.bar = (unsigned*)(F.ctl() + CW_BAR); bar.x = 0; bar.st = nullptr;
    if (use_bar) bar = xcd_barrier_post((unsigned*)(F.ctl() + CW_BAR), F.MISC + 8);

    if (IN(0)) { REP(0x2000) ph_prologue(F); SEAM(0); }
    layer_phases<0>(F, lo, hi, bar, lds);
    layer_phases<1>(F, lo, hi, bar, lds);
    if (IN(23)) { if (DBG_DUP & 0x8000) ph_final(F, true); ph_final(F, false); }
#undef IN
#undef SEAM
}


#if defined(DBG_NAIVE)
__global__ void __launch_bounds__(256) naive_attn(unsigned char* ws, const float* win_sink, int l, int mode) {
    bf16* PROJ = (bf16*)(ws + WS_PROJ);
    const int nrows = (mode < 2) ? ROWS_LAT : ROWS_CTX;
    const long idx = (long)blockIdx.x * 256 + threadIdx.x; if (idx >= (long)nrows * 8) return;
    const int h = (int)(idx / nrows), rr = (int)(idx % nrows), g = h >> 2;
    const int b = (mode < 2) ? (rr >> 14) : (rr >> 8); const int t = (mode < 2) ? (rr & 16383) : 0;
    const int row = (mode < 2) ? ROWS_CTX + rr : rr;
    const bool glob = (mode == 0 || mode == 3);
    bf16* qp = PROJ + (glob ? PJ_GQ : PJ_WQ) + (size_t)row * 512 + h * 64;
    const bf16* KV = PROJ + (glob ? PJ_GKV : PJ_WKV);
    float q[64], o[64];
#pragma unroll
    for (int d = 0; d < 64; ++d) { q[d] = bf2f(qp[d]); o[d] = 0.f; }
    float m = -INFINITY, lsum = 0.f;
    const int nctx = 256; int k_lo = 0, k_hi = -1;
    if (mode == 0) { k_lo = 0; k_hi = SEQ - 1; } else if (mode == 1) { k_lo = max(t - 128, 0); k_hi = min(t + 128, SEQ - 1); }
    const int ntot = nctx + (k_hi - k_lo + 1);
    for (int j = 0; j < ntot; ++j) {
        const int krow = j < nctx ? b * 256 + j : ROWS_CTX + b * SEQ + k_lo + (j - nctx);
        const bf16* kp = KV + (size_t)krow * 256 + g * 64; const bf16* vp = kp + 128;
        float s = 0.f;
#pragma unroll
        for (int d = 0; d < 64; ++d) s += q[d] * bf2f(kp[d]);
        const float mn = fmaxf(m, s), f = exp2f(m - mn), p = exp2f(s - mn);
        lsum = lsum * f + p;
#pragma unroll
        for (int d = 0; d < 64; ++d) o[d] = o[d] * f + p * bf2f(vp[d]);
        m = mn;
    }
    if (mode == 1 || mode == 2) lsum += exp2f(win_sink[l * 8 + h] * 1.4426950408889634f - m);
    const float inv = 1.0f / lsum;
#pragma unroll
    for (int d = 0; d < 64; ++d) qp[d] = (bf16)f2bf(o[d] * inv);
}
__global__ void __launch_bounds__(192) naive_mlstm(unsigned char* ws) {
    __shared__ float sq[128], sk[128], sden;
    bf16* PROJ = (bf16*)(ws + WS_PROJ); const float* gatesf = (const float*)(ws + WS_GATESF); bf16* HD = (bf16*)(ws + WS_MERGED);
    const int chain = blockIdx.x, b = chain >> 3, dir = (chain >> 2) & 1, h = chain & 3, dv = threadIdx.x;
    float C[128];
#pragma unroll
    for (int i = 0; i < 128; ++i) C[i] = 0.f;
    const float scale = 0.08838834764831845f;
    for (int step = 0; step < 256 + SEQ; ++step) {
        int row;
        if (step < 256) row = b * 256 + (dir ? 255 - step : step); else { const int tt = step - 256; row = ROWS_CTX + b * SEQ + (dir ? SEQ - 1 - tt : tt); }
        __syncthreads();
        if (dv < 128) { sq[dv] = bf2f(PROJ[PJ_MLQ + (size_t)row * 512 + h * 128 + dv]); sk[dv] = bf2f(PROJ[PJ_MLK + (size_t)row * 512 + h * 128 + dv]); }
        const float ig = gatesf[(size_t)row * 16 + dir * 4 + h], fg = gatesf[(size_t)row * 16 + 8 + dir * 4 + h];
        const float fw = expf(log_sigmoid_f(fg)), iw = expf(ig);
        const float v = dv < 128 ? bf2f(PROJ[PJ_MLV + (size_t)row * 512 + h * 128 + dv]) : 1.0f;
        __syncthreads();
        float num = 0.f;
        if (dv < 129) {
#pragma unroll
            for (int i = 0; i < 128; ++i) { C[i] = fw * C[i] + iw * sk[i] * v; num += sq[i] * C[i]; }
            num *= scale;
            if (dv == 128) sden = num;
        }
        __syncthreads();
        if (dv < 128) HD[((size_t)dir * ROWS + row) * 512 + h * 128 + dv] = (bf16)f2bf(num / fmaxf(fabsf(sden), 1.0f));
    }
}
__global__ void __launch_bounds__(256) naive_mlstm_finish(unsigned char* ws, const float* ml_norm_g, int l, int row_lo) {
    bf16* PROJ = (bf16*)(ws + WS_PROJ); const bf16* HD = (const bf16*)(ws + WS_MERGED);
    const int gw = blockIdx.x * 4 + (threadIdx.x >> 6), lane = threadIdx.x & 63; const int nitems = (ROWS - row_lo) * 4; if (gw >= nitems) return;
    const int row = row_lo + gw / 4, h = gw % 4;
    const float v0 = bf2f(HD[(size_t)row * 512 + h * 128 + 2 * lane]) + bf2f(HD[((size_t)ROWS + row) * 512 + h * 128 + 2 * lane]);
    const float v1 = bf2f(HD[(size_t)row * 512 + h * 128 + 2 * lane + 1]) + bf2f(HD[((size_t)ROWS + row) * 512 + h * 128 + 2 * lane + 1]);
    float ss = v0 * v0 + v1 * v1;
#pragma unroll
    for (int o = 1; o < 64; o <<= 1) ss += __shfl_xor(ss, o);
    const float r = 1.0f / sqrtf(ss * (1.0f / 128.0f) + NORM_EPS);
    const float* gn = ml_norm_g + (size_t)(l * 4 + h) * 128;
    const float o0 = bf2f(PROJ[PJ_MLO + (size_t)row * 512 + h * 128 + 2 * lane]), o1 = bf2f(PROJ[PJ_MLO + (size_t)row * 512 + h * 128 + 2 * lane + 1]);
    PROJ[PJ_MLQ + (size_t)row * 512 + h * 128 + 2 * lane] = (bf16)f2bf(v0 * r * gn[2 * lane] / (1.0f + expf(-o0)));
    PROJ[PJ_MLQ + (size_t)row * 512 + h * 128 + 2 * lane + 1] = (bf16)f2bf(v1 * r * gn[2 * lane + 1] / (1.0f + expf(-o1)));
}
#endif

#if defined(DBG_NGEMM)
template <int NACC, class WLoad, class Epi> __global__ void __launch_bounds__(256) naive_gemm(const bf16* A, int lda, int K, WLoad wl, Epi epi) {
    __shared__ float As[16][132]; __shared__ float Ws[NACC][16][68];
    const int tid = threadIdx.x, tx = tid & 15, ty = tid >> 4; const int m0 = blockIdx.y * 128, n0 = blockIdx.x * 64;
    float acc[NACC][8][4];
#pragma unroll
    for (int a = 0; a < NACC; ++a)
#pragma unroll
        for (int i = 0; i < 8; ++i)
#pragma unroll
            for (int j = 0; j < 4; ++j) acc[a][i][j] = 0.f;
    for (int k0 = 0; k0 < K; k0 += 16) {
#pragma unroll
        for (int i = 0; i < 8; ++i) { const int idx = tid + 256 * i, r = idx >> 4, kk = idx & 15; As[kk][r] = bf2f(A[(size_t)(m0 + r) * lda + k0 + kk]); }
#pragma unroll
        for (int a = 0; a < NACC; ++a)
#pragma unroll
            for (int i = 0; i < 4; ++i) { const int idx = tid + 256 * i, kk = idx >> 6, c = idx & 63; Ws[a][kk][c] = wl(a, k0 + kk, n0 + c); }
        __syncthreads();
#pragma unroll
        for (int kk = 0; kk < 16; ++kk) { float av[8];
#pragma unroll
            for (int i = 0; i < 8; ++i) av[i] = As[kk][ty * 8 + i];
#pragma unroll
            for (int a = 0; a < NACC; ++a) { float wv[4];
#pragma unroll
                for (int j = 0; j < 4; ++j) wv[j] = Ws[a][kk][tx * 4 + j];
#pragma unroll
                for (int i = 0; i < 8; ++i)
#pragma unroll
                    for (int j = 0; j < 4; ++j) acc[a][i][j] += av[i] * wv[j]; } }
        __syncthreads();
    }
#pragma unroll
    for (int i = 0; i < 8; ++i)
#pragma unroll
        for (int j = 0; j < 4; ++j) { float v[NACC];
#pragma unroll
            for (int a = 0; a < NACC; ++a) v[a] = acc[a][i][j];
            epi(m0 + ty * 8 + i, n0 + tx * 4 + j, v); }
}
struct NWPlain { const float* W; int ldw; int col0; __device__ float operator()(int, int k, int n) const { return W[(size_t)k * ldw + col0 + n]; } };
struct NWProj { const float* W; __device__ static int src(int n) { return n < 2048 ? n : n < 2560 ? 2064 + (n - 2048) : n < 3072 ? 2832 + (n - 2560) : n < 3328 ? 2576 + (n - 3072) : 3344 + (n - 3328); }
    __device__ float operator()(int, int k, int n) const { return W[(size_t)k * DIN + src(n)]; } };
struct NWBt { const bf16* Bt; int K; __device__ float operator()(int, int k, int n) const { return bf2f(Bt[(size_t)n * K + k]); } };
struct NWPair { const float* W1; const float* W3; __device__ float operator()(int a, int k, int n) const { return (a ? W3 : W1)[(size_t)k * DFF + n]; } };
struct NEProj { bf16* P; const float* b_in; __device__ void operator()(int m, int n, const float* v) const {
        const float x = v[0] + b_in[NWProj::src(n)]; size_t off; int ldc, c;
        if (n < 2048) { const int a = n >> 9; off = a == 0 ? PJ_MLQ : a == 1 ? PJ_MLK : a == 2 ? PJ_MLV : PJ_MLO; ldc = 512; c = n & 511; }
        else if (n < 2560) { off = PJ_WQ; ldc = 512; c = n - 2048; } else if (n < 3072) { off = PJ_GQ; ldc = 512; c = n - 2560; }
        else if (n < 3328) { off = PJ_WKV; ldc = 256; c = n - 3072; } else { off = PJ_GKV; ldc = 256; c = n - 3328; }
        P[off + (size_t)m * ldc + c] = (bf16)f2bf(x); } };
struct NEGate { bf16* G; const float* b_in; int r0, pad; __device__ void operator()(int m, int n, const float* v) const { const float x = v[0] + b_in[3600 + n]; G[(size_t)(r0 + m) * NGATE + n] = (bf16)f2bf(1.0f / (1.0f + expf(-x))); } };
struct NEMerge { const bf16* G; bf16* O; int r0, first; __device__ void operator()(int m, int n, const float* v) const { const size_t row = r0 + m; float x = v[0] * bf2f(G[row * NGATE + n]); if (!first) x += bf2f(O[row * 1024 + n]); O[row * 1024 + n] = (bf16)f2bf(x); } };
struct NEResid { const float* old_ctx; const float* old_lat; float* new_ctx; float* new_lat; const float* mod; int r0, pad; __device__ void operator()(int m, int n, const float* v) const {
        const int row = r0 + m; const bool isctx = row < ROWS_CTX; const int which = isctx ? 2 : ((row - ROWS_CTX) >> 14);
        const float xo = isctx ? old_ctx[(size_t)row * 1024 + n] : old_lat[(size_t)(row - ROWS_CTX) * 1024 + n];
        float* xn = isctx ? new_ctx + (size_t)row * 1024 + n : new_lat + (size_t)(row - ROWS_CTX) * 1024 + n;
        *xn = xo + mod[which * 6144 + n] * v[0]; } };
struct NEFfn1 { bf16* H; int r0, pad; __device__ void operator()(int m, int n, const float* v) const { H[(size_t)(r0 + m) * DFF + n] = (bf16)f2bf(v[0] / (1.0f + expf(-v[0])) * v[1]); } };
#endif

extern "C" void kernel_launch(void* const* d_in, const int* in_sizes, int n_in, void* d_out, int out_size, void* d_ws, size_t ws_size, hipStream_t stream) {
    static int grid = 0;
    if (grid == 0) {
        if (n_in != 20 || out_size != ROWS_LAT * 1024 || ws_size < WS_END) { fprintf(stderr, "kernel_launch: unexpected problem shape (n_in %d, out %d, ws %zu); nothing launched\n", n_in, out_size, ws_size); grid = -1; return; }
        int dev = 0, cus = 0, per_cu = 0;
        if (hipGetDevice(&dev) != hipSuccess || hipDeviceGetAttribute(&cus, hipDeviceAttributeMultiprocessorCount, dev) != hipSuccess) { grid = -1; return; }
        if (hipFuncSetAttribute((const void*)fwd_kernel, hipFuncAttributeMaxDynamicSharedMemorySize, LDS_BYTES) != hipSuccess) { fprintf(stderr, "kernel_launch: hipFuncSetAttribute failed\n"); grid = -1; return; }
        if (hipOccupancyMaxActiveBlocksPerMultiprocessor(&per_cu, (const void*)fwd_kernel, NWAVES * 64, LDS_BYTES) != hipSuccess || per_cu < 1) { fprintf(stderr, "kernel_launch: occupancy query reports %d workgroups per CU\n", per_cu); }
        (void)hipGetLastError();
        grid = cus;
    }
    if (grid < 0) return;
    if (hipMemsetAsync((char*)d_ws + WS_CTL, 0, CTL_ZERO_BYTES, stream) != hipSuccess) return;
    Args a{};
    for (int i = 0; i < 20; ++i) a.in[i] = (const float*)d_in[i];
    a.out = (float*)d_out; a.ws = (unsigned char*)d_ws;
#if MK_LAUNCH_PER_PHASE
    for (int p = 0; p < N_PHASES; ++p) {
#if defined(DBG_NAIVE)
        const int lp = (p >= 1 && p <= 22) ? (p - 1) % 11 : -1, ll = (p - 1) / 11;
        if (lp == 4) {
            a.ph_lo = p; a.ph_hi = p + 1;
            hipLaunchKernelGGL(fwd_kernel, dim3(grid), dim3(NWAVES * 64), LDS_BYTES, stream, a);
            unsigned char* wsb = (unsigned char*)d_ws;
            if (DBG_NAIVE & 1) { hipLaunchKernelGGL(naive_mlstm, dim3(16), dim3(192), 0, stream, wsb); hipLaunchKernelGGL(naive_mlstm_finish, dim3(ROWS), dim3(256), 0, stream, wsb, (const float*)d_in[9], ll, 0); }
            if (DBG_NAIVE & 2) { hipLaunchKernelGGL(naive_attn, dim3(ROWS_LAT * 8 / 256), dim3(256), 0, stream, wsb, (const float*)d_in[10], ll, 1); if (ll == 0) hipLaunchKernelGGL(naive_attn, dim3(ROWS_CTX * 8 / 256), dim3(256), 0, stream, wsb, (const float*)d_in[10], ll, 2); }
            if (DBG_NAIVE & 4) { hipLaunchKernelGGL(naive_attn, dim3(ROWS_LAT * 8 / 256), dim3(256), 0, stream, wsb, (const float*)d_in[10], ll, 0); if (ll == 0) hipLaunchKernelGGL(naive_attn, dim3(ROWS_CTX * 8 / 256), dim3(256), 0, stream, wsb, (const float*)d_in[10], ll, 3); }
            continue;
        }
#endif
#if defined(DBG_NGEMM)
        {
            const int lq = (p >= 1 && p <= 22) ? (p - 1) % 11 : -1, L = (p - 1) / 11; unsigned char* wsb = (unsigned char*)d_ws;
            bf16* HXp = (bf16*)(wsb + WS_HX); bf16* PJ = (bf16*)(wsb + WS_PROJ); bf16* MG = (bf16*)(wsb + WS_MERGED); float* SMALLp = (float*)(wsb + WS_SMALL); float* XC = (float*)(wsb + WS_XC);
            const float* w_in = (const float*)d_in[7] + (size_t)L * 1024 * DIN; const float* b_in = (const float*)d_in[8] + (size_t)L * DIN;
            const int r0b = (L == 1) ? ROWS_CTX : 0, Mr = ROWS - r0b; const float* modl = SMALLp + SM_MODV + L * 3 * 6144;
            if (lq == 1 && (DBG_NGEMM & 1)) { hipLaunchKernelGGL((naive_gemm<1, NWProj, NEProj>), dim3(NPROJ / 64, ROWS / 128), dim3(256), 0, stream, HXp, 1024, 1024, NWProj{w_in}, NEProj{PJ, b_in}); continue; }
            if (lq == 5 && (DBG_NGEMM & 128)) { a.ph_lo = p; a.ph_hi = p + 1; hipLaunchKernelGGL(fwd_kernel, dim3(grid), dim3(NWAVES * 64), LDS_BYTES, stream, a); }
            if (lq == 5 && (DBG_NGEMM & 64)) { hipLaunchKernelGGL((naive_gemm<1, NWBt, NEGate>), dim3(NGATE / 64, Mr / 128), dim3(256), 0, stream, HXp + (size_t)r0b * 1024, 1024, 1024, NWBt{(const bf16*)(wsb + (L ? WS_W2 : WS_W)) + W_G, 1024}, NEGate{PJ + PJ_MLK, b_in, r0b, 0}); continue; }
            if (lq == 5 && (DBG_NGEMM & 2)) { hipLaunchKernelGGL((naive_gemm<1, NWPlain, NEGate>), dim3(NGATE / 64, Mr / 128), dim3(256), 0, stream, HXp + (size_t)r0b * 1024, 1024, 1024, NWPlain{w_in, DIN, 3600}, NEGate{PJ + PJ_MLK, b_in, r0b, 0}); continue; }
            if (lq == 6 && (DBG_NGEMM & 4)) { for (int br = 0; br < 3; ++br) { const size_t yo = br == 0 ? PJ_MLQ : br == 1 ? PJ_WQ : PJ_GQ;
                    hipLaunchKernelGGL((naive_gemm<1, NWPlain, NEMerge>), dim3(1024 / 64, Mr / 128), dim3(256), 0, stream, PJ + yo + (size_t)r0b * 512, 512, 512, NWPlain{(const float*)d_in[13] + (size_t)(L * 3 + br) * 512 * 1024, 1024, 0}, NEMerge{PJ + PJ_MLK + br * 1024, MG, r0b, br == 0}); } continue; }
            if (lq == 7 && (DBG_NGEMM & 8)) { hipLaunchKernelGGL((naive_gemm<1, NWPlain, NEResid>), dim3(1024 / 64, Mr / 128), dim3(256), 0, stream, MG + (size_t)r0b * 1024, 1024, 1024, NWPlain{(const float*)d_in[14] + (size_t)L * 1024 * 1024, 1024, 0},
                    NEResid{L == 0 ? (const float*)d_in[2] : XC, L == 0 ? (const float*)d_in[0] : (float*)d_out, XC, (float*)d_out, modl + 2048, r0b, 0}); continue; }
            if (lq == 9 && (DBG_NGEMM & 16)) { hipLaunchKernelGGL((naive_gemm<2, NWPair, NEFfn1>), dim3(DFF / 64, Mr / 128), dim3(256), 0, stream, HXp + (size_t)r0b * 1024, 1024, 1024, NWPair{(const float*)d_in[16] + (size_t)L * 1024 * DFF, (const float*)d_in[17] + (size_t)L * 1024 * DFF}, NEFfn1{PJ, r0b, 0}); continue; }
            if (lq == 10 && (DBG_NGEMM & 32)) { hipLaunchKernelGGL((naive_gemm<1, NWPlain, NEResid>), dim3(1024 / 64, Mr / 128), dim3(256), 0, stream, PJ + (size_t)r0b * DFF, DFF, DFF, NWPlain{(const float*)d_in[18] + (size_t)L * DFF * 1024, 1024, 0},
                    NEResid{XC, (float*)d_out, XC, (float*)d_out, modl + 5120, r0b, 0}); continue; }
        }
#endif
        a.ph_lo = p; a.ph_hi = p + 1; hipLaunchKernelGGL(fwd_kernel, dim3(grid), dim3(NWAVES * 64), LDS_BYTES, stream, a); }
#else
    a.ph_lo = 0; a.ph_hi = N_PHASES;
    hipLaunchKernelGGL(fwd_kernel, dim3(grid), dim3(NWAVES * 64), LDS_BYTES, stream, a);
#endif
}
```
